# Optimizing an MI355X kernel written in HIP

```python
import math
import jax
import jax.numpy as jnp
from jax import lax
import numpy as np

D_MODEL = 2048
BATCH = 4
SEQ = 8192
DEPTH = 2

CTX_LEN = 256
GRID_W = 64
N_BRANCH = 3
BRANCH_WIDTH = 1024
N_HEADS = 8
N_KV_HEADS = 2
HEAD_DIM = 128
GROUP = N_HEADS // N_KV_HEADS
WINDOW = 128
Q_BLOCK = 128
ROPE_BASE = 10000.0
RNN_WIDTH = BRANCH_WIDTH
RNN_BLOCKS = 8
RNN_BLOCK = RNN_WIDTH // RNN_BLOCKS
RNN_CONV = 4
RNN_CONV_LEFT = 2
LRU_C = 8.0
SC_WIDTH = BRANCH_WIDTH
SC_CONV = 3
SC_CONV_LEFT = 1
D_FF = 5504
N_MOD = 9
EPS = 1e-6
NEG_INF = -1e30
IN_SIZES = (RNN_WIDTH, RNN_WIDTH, SC_WIDTH, SC_WIDTH, SC_WIDTH,
            N_HEADS * HEAD_DIM, N_KV_HEADS * HEAD_DIM, N_KV_HEADS * HEAD_DIM,
            N_BRANCH * D_MODEL)
IN_COLS = sum(IN_SIZES)

kernel_name = "hybrid_rglru_shortconv_swa_diffusion_block"


def rmsnorm(x, g):
    xf = x.astype(jnp.float32)
    y = xf * lax.rsqrt(jnp.mean(xf * xf, axis=-1, keepdims=True) + EPS)
    return (y * g.astype(jnp.float32)).astype(x.dtype)


def modulate(x, shift, scale):
    return x * (1 + scale) + shift


def swiglu(u, w13, w2):
    gu = u @ w13
    gate, up = gu[..., :D_FF], gu[..., D_FF:]
    return (jax.nn.silu(gate) * up) @ w2


def split_in(z):
    out, start = [], 0
    for n in IN_SIZES:
        out.append(z[..., start:start + n])
        start += n
    return out


def dwconv(x, w, left):
    k_w, ch = w.shape
    return lax.conv_general_dilated(
        x, w[:, None, :], window_strides=(1,), padding=[(left, k_w - 1 - left)],
        dimension_numbers=("NWC", "WIO", "NWC"), feature_group_count=ch)


def axial_rope(n_tok):
    rows = n_tok // GRID_W
    row = jnp.repeat(jnp.arange(rows), GRID_W).astype(jnp.float32)
    col = jnp.tile(jnp.arange(GRID_W), rows).astype(jnp.float32)
    half = HEAD_DIM // 2
    inv = ROPE_BASE ** (-jnp.arange(0, half, 2, dtype=jnp.float32) / half)
    ang = jnp.concatenate([row[:, None] * inv, col[:, None] * inv], axis=-1)
    ang = ang.reshape(n_tok, 2, half // 2)
    return jnp.cos(ang), jnp.sin(ang)


def apply_rope(x, cos, sin):
    b, l, h, d = x.shape
    xr = x.astype(jnp.float32).reshape(b, l, h, 2, 2, d // 4)
    x1, x2 = xr[..., 0, :], xr[..., 1, :]
    cs, sn = cos[None, :, None], sin[None, :, None]
    out = jnp.stack([x1 * cs - x2 * sn, x2 * cs + x1 * sn], axis=-2)
    return out.reshape(b, l, h, d).astype(x.dtype)


def linear_scan(a, b, h0):
    def combine(e1, e2):
        a1, b1 = e1
        a2, b2 = e2
        return a1 * a2, a2 * b1 + b2
    a_cum, b_cum = lax.associative_scan(combine, (a, b), axis=1)
    return b_cum + a_cum * h0[:, None, :]


def rglru(x, w_a, b_a, w_x, b_x, lam, h0, reverse):
    b, l, r = x.shape
    xb = x.reshape(b, l, RNN_BLOCKS, RNN_BLOCK)
    rg = jax.nn.sigmoid((jnp.einsum("blnd,nde->blne", xb, w_a).reshape(b, l, r) + b_a).astype(jnp.float32))
    ig = jax.nn.sigmoid((jnp.einsum("blnd,nde->blne", xb, w_x).reshape(b, l, r) + b_x).astype(jnp.float32))
    log_a = -LRU_C * rg * jax.nn.softplus(-lam.astype(jnp.float32))
    a = jnp.exp(log_a)
    u = jnp.sqrt(-jnp.expm1(2.0 * log_a)) * (ig * x.astype(jnp.float32))
    if reverse:
        a, u = jnp.flip(a, axis=1), jnp.flip(u, axis=1)
    h = linear_scan(a, u, h0)
    h_last = h[:, -1]
    if reverse:
        h = jnp.flip(h, axis=1)
    return h.astype(x.dtype), h_last


def sink_softmax(logits, sink):
    s = jnp.broadcast_to(sink.astype(jnp.float32)[None, :, :, None, None], logits.shape[:-1] + (1,))
    p = jax.nn.softmax(jnp.concatenate([s, logits], axis=-1), axis=-1)
    return p[..., 1:]


def banded_attention(q, k, v, kc, vc, sink):
    b, l = q.shape[0], q.shape[1]
    nblk = l // Q_BLOCK
    scale = HEAD_DIM ** -0.5
    qb = q.reshape(b, nblk, Q_BLOCK, N_KV_HEADS, GROUP, HEAD_DIM)
    pad = ((0, 0), (Q_BLOCK, Q_BLOCK), (0, 0), (0, 0))
    kp, vp = jnp.pad(k, pad), jnp.pad(v, pad)
    span = 3 * Q_BLOCK
    offs_q = jnp.arange(Q_BLOCK)
    offs_k = jnp.arange(span) - Q_BLOCK

    def block(n):
        qn = lax.dynamic_index_in_dim(qb, n, axis=1, keepdims=False)
        kn = lax.dynamic_slice_in_dim(kp, n * Q_BLOCK, span, axis=1)
        vn = lax.dynamic_slice_in_dim(vp, n * Q_BLOCK, span, axis=1)
        qpos = n * Q_BLOCK + offs_q
        kpos = n * Q_BLOCK + offs_k
        valid = (jnp.abs(qpos[:, None] - kpos[None, :]) <= WINDOW) & (kpos >= 0)[None, :] & (kpos < l)[None, :]
        s_loc = jnp.einsum("bqkgd,bskd->bkgqs", qn, kn).astype(jnp.float32) * scale
        s_loc = jnp.where(valid, s_loc, NEG_INF)
        s_ctx = jnp.einsum("bqkgd,bckd->bkgqc", qn, kc).astype(jnp.float32) * scale
        p = sink_softmax(jnp.concatenate([s_loc, s_ctx], axis=-1), sink).astype(v.dtype)
        return (jnp.einsum("bkgqs,bskd->bqkgd", p[..., :span], vn)
                + jnp.einsum("bkgqc,bckd->bqkgd", p[..., span:], vc))

    out = lax.map(block, jnp.arange(nblk))
    return jnp.moveaxis(out, 0, 1).reshape(b, l, N_HEADS * HEAD_DIM)


def context_attention(qc, kc, vc, sink):
    b, n = qc.shape[0], qc.shape[1]
    s = jnp.einsum("bqkgd,bckd->bkgqc", qc, kc).astype(jnp.float32) * (HEAD_DIM ** -0.5)
    p = sink_softmax(s, sink).astype(vc.dtype)
    return jnp.einsum("bkgqc,bckd->bqkgd", p, vc).reshape(b, n, N_HEADS * HEAD_DIM)


def merge_branches(ys, g, b_merge, w_branch, w_out):
    gates = jax.nn.sigmoid(g.reshape(g.shape[:-1] + (N_BRANCH, D_MODEL)) + b_merge)
    merged = gates[..., 0, :] * (ys[0] @ w_branch[0])
    for i in range(1, N_BRANCH):
        merged = merged + gates[..., i, :] * (ys[i] @ w_branch[i])
    return merged @ w_out


def token_mixer(u, uc, cos, sin, w_in, b_merge, rnn_conv_w, rnn_conv_b, lru_w_a, lru_b_a,
                lru_w_x, lru_b_x, lru_lambda, sc_conv_w, attn_sink, w_branch, w_out, with_ctx_out):
    b, l, _ = u.shape
    n_ctx = uc.shape[1]
    rx, rg, sb, scg, sx, q, k, v, g = split_in(u @ w_in)
    rxc, rgc, sbc, scgc, sxc, qc, kc, vc, gc = split_in(uc @ w_in)

    xa = dwconv(rx, rnn_conv_w, RNN_CONV_LEFT) + rnn_conv_b
    xac = dwconv(rxc, rnn_conv_w, RNN_CONV_LEFT) + rnn_conv_b
    h0 = jnp.zeros((b, RNN_WIDTH), jnp.float32)
    hc_f, last_f = rglru(xac, lru_w_a[0], lru_b_a[0], lru_w_x[0], lru_b_x[0], lru_lambda[0], h0, False)
    hc_b, last_b = rglru(xac, lru_w_a[1], lru_b_a[1], lru_w_x[1], lru_b_x[1], lru_lambda[1], h0, True)
    hl_f, _ = rglru(xa, lru_w_a[0], lru_b_a[0], lru_w_x[0], lru_b_x[0], lru_lambda[0], last_f, False)
    hl_b, _ = rglru(xa, lru_w_a[1], lru_b_a[1], lru_w_x[1], lru_b_x[1], lru_lambda[1], last_b, True)
    ya = (hl_f + hl_b) * jax.nn.gelu(rg)

    yb = sb * dwconv(scg * sx, sc_conv_w, SC_CONV_LEFT)

    sink = attn_sink.reshape(N_KV_HEADS, GROUP)
    q = apply_rope(q.reshape(b, l, N_HEADS, HEAD_DIM), cos, sin).reshape(b, l, N_KV_HEADS, GROUP, HEAD_DIM)
    k = apply_rope(k.reshape(b, l, N_KV_HEADS, HEAD_DIM), cos, sin)
    v = v.reshape(b, l, N_KV_HEADS, HEAD_DIM)
    kc = kc.reshape(b, n_ctx, N_KV_HEADS, HEAD_DIM)
    vc = vc.reshape(b, n_ctx, N_KV_HEADS, HEAD_DIM)
    yatt = banded_attention(q, k, v, kc, vc, sink)

    y = merge_branches((ya, yb, yatt), g, b_merge, w_branch, w_out)
    if not with_ctx_out:
        return y, None

    yac = (hc_f + hc_b) * jax.nn.gelu(rgc)
    ybc = sbc * dwconv(scgc * sxc, sc_conv_w, SC_CONV_LEFT)
    yattc = context_attention(qc.reshape(b, n_ctx, N_KV_HEADS, GROUP, HEAD_DIM), kc, vc, sink)
    yc = merge_branches((yac, ybc, yattc), gc, b_merge, w_branch, w_out)
    return y, yc


def setup_inputs(seed: int = 0) -> dict:
    key = jax.random.key(seed)
    ks = jax.random.split(key, 32)
    f32 = jnp.float32

    def nrm(k, shape, scale):
        return jax.random.normal(k, shape, f32) * scale

    a_c = jax.random.uniform(ks[15], (DEPTH, 2, RNN_WIDTH), f32, minval=0.9, maxval=0.999)
    s_l = a_c ** (1.0 / LRU_C)
    lam = jnp.log(s_l) - jnp.log1p(-s_l)
    return {
        "x": nrm(ks[0], (BATCH, SEQ, D_MODEL), 1.0),
        "c": nrm(ks[1], (BATCH, D_MODEL), 1.0),
        "ctx": nrm(ks[2], (BATCH, CTX_LEN, D_MODEL), 1.0),
        "c_ctx": nrm(ks[3], (D_MODEL,), 1.0),
        "ada_w": nrm(ks[4], (DEPTH, D_MODEL, N_MOD * D_MODEL), 0.5 * D_MODEL ** -0.5),
        "ada_b": nrm(ks[5], (DEPTH, N_MOD * D_MODEL), 0.02),
        "norm_g": 1.0 + nrm(ks[6], (DEPTH, 3, D_MODEL), 0.02),
        "ffn1_w13": nrm(ks[7], (DEPTH, D_MODEL, 2 * D_FF), D_MODEL ** -0.5),
        "ffn1_w2": nrm(ks[8], (DEPTH, D_FF, D_MODEL), D_FF ** -0.5),
        "w_in": nrm(ks[9], (DEPTH, D_MODEL, IN_COLS), D_MODEL ** -0.5),
        "b_merge": nrm(ks[10], (DEPTH, N_BRANCH, D_MODEL), 0.02),
        "rnn_conv_w": nrm(ks[11], (DEPTH, RNN_CONV, RNN_WIDTH), RNN_CONV ** -0.5),
        "rnn_conv_b": nrm(ks[12], (DEPTH, RNN_WIDTH), 0.02),
        "lru_w_a": nrm(ks[13], (DEPTH, 2, RNN_BLOCKS, RNN_BLOCK, RNN_BLOCK), RNN_BLOCK ** -0.5),
        "lru_b_a": nrm(ks[14], (DEPTH, 2, RNN_WIDTH), 0.02),
        "lru_w_x": nrm(ks[16], (DEPTH, 2, RNN_BLOCKS, RNN_BLOCK, RNN_BLOCK), RNN_BLOCK ** -0.5),
        "lru_b_x": nrm(ks[17], (DEPTH, 2, RNN_WIDTH), 0.02),
        "lru_lambda": lam,
        "sc_conv_w": nrm(ks[18], (DEPTH, SC_CONV, SC_WIDTH), SC_CONV ** -0.5),
        "attn_sink": nrm(ks[19], (DEPTH, N_HEADS), 0.5),
        "w_branch": nrm(ks[20], (DEPTH, N_BRANCH, BRANCH_WIDTH, D_MODEL), BRANCH_WIDTH ** -0.5),
        "w_out": nrm(ks[21], (DEPTH, D_MODEL, D_MODEL), D_MODEL ** -0.5),
        "ffn2_w13": nrm(ks[22], (DEPTH, D_MODEL, 2 * D_FF), D_MODEL ** -0.5),
        "ffn2_w2": nrm(ks[23], (DEPTH, D_FF, D_MODEL), D_FF ** -0.5),
        "final_norm_g": 1.0 + nrm(ks[24], (D_MODEL,), 0.02),
    }


def reference(x, c, ctx, c_ctx, ada_w, ada_b, norm_g, ffn1_w13, ffn1_w2, w_in, b_merge,
              rnn_conv_w, rnn_conv_b, lru_w_a, lru_b_a, lru_w_x, lru_b_x, lru_lambda,
              sc_conv_w, attn_sink, w_branch, w_out, ffn2_w13, ffn2_w2, final_norm_g):
    b, l, _ = x.shape
    cos, sin = axial_rope(l)
    silu_c = jax.nn.silu(c)
    silu_cc = jax.nn.silu(c_ctx)
    h, hc = x, ctx
    for layer in range(DEPTH):
        last = layer == DEPTH - 1
        mod = (silu_c @ ada_w[layer] + ada_b[layer]).reshape(b, N_MOD, 1, D_MODEL)
        modc = (silu_cc @ ada_w[layer] + ada_b[layer]).reshape(N_MOD, D_MODEL)

        u = modulate(rmsnorm(h, norm_g[layer, 0]), mod[:, 0], mod[:, 1])
        h = h + 0.5 * mod[:, 2] * swiglu(u, ffn1_w13[layer], ffn1_w2[layer])
        uc = modulate(rmsnorm(hc, norm_g[layer, 0]), modc[0], modc[1])
        hc = hc + 0.5 * modc[2] * swiglu(uc, ffn1_w13[layer], ffn1_w2[layer])

        u = modulate(rmsnorm(h, norm_g[layer, 1]), mod[:, 3], mod[:, 4])
        uc = modulate(rmsnorm(hc, norm_g[layer, 1]), modc[3], modc[4])
        y, yc = token_mixer(u, uc, cos, sin, w_in[layer], b_merge[layer], rnn_conv_w[layer],
                            rnn_conv_b[layer], lru_w_a[layer], lru_b_a[layer], lru_w_x[layer],
                            lru_b_x[layer], lru_lambda[layer], sc_conv_w[layer], attn_sink[layer],
                            w_branch[layer], w_out[layer], not last)
        h = h + mod[:, 5] * y

        u = modulate(rmsnorm(h, norm_g[layer, 2]), mod[:, 6], mod[:, 7])
        h = h + 0.5 * mod[:, 8] * swiglu(u, ffn2_w13[layer], ffn2_w2[layer])
        if not last:
            hc = hc + modc[5] * yc
            uc = modulate(rmsnorm(hc, norm_g[layer, 2]), modc[6], modc[7])
            hc = hc + 0.5 * modc[8] * swiglu(uc, ffn2_w13[layer], ffn2_w2[layer])
    return rmsnorm(h, final_norm_g)
```

```cpp
#include <hip/hip_runtime.h>
#include <cstdio>
#include <cstdint>

#ifndef MK_ONE_LAUNCH
#define MK_ONE_LAUNCH 1
#endif

#define LAS __attribute__((address_space(3)))
#define GAS __attribute__((address_space(1)))
typedef unsigned short bf16_t;
typedef short bf16x8 __attribute__((ext_vector_type(8)));
typedef short s16x4 __attribute__((ext_vector_type(4)));
typedef float f32x4 __attribute__((ext_vector_type(4)));
typedef float f32x2 __attribute__((ext_vector_type(2)));
typedef float f32x16 __attribute__((ext_vector_type(16)));
typedef unsigned u32x4 __attribute__((ext_vector_type(4)));
typedef unsigned u32x2 __attribute__((ext_vector_type(2)));

constexpr int DM = 2048, NB = 4, SEQ = 8192, CTXL = 256, DFF = 5504, NMOD = 9;
constexpr int MC = NB * CTXL;
constexpr int ML = NB * SEQ;
constexpr int MT = MC + ML;
constexpr int NZS = 6656, NGC = 6144, SWLD = 12800;
constexpr int INC = 12800;
constexpr int NCHUNK = MT / 128;
constexpr int SEQV = CTXL + SEQ;
constexpr float EPS = 1e-6f;
constexpr float LOG2E = 1.4426950408889634f;

constexpr size_t MiB = 1u << 20;
constexpr size_t WS_CTL = 0, CTL_ZERO_BYTES = 4 * MiB;
constexpr size_t WS_SSQ = 1 * MiB;
constexpr size_t WS_MOD = 4 * MiB;
constexpr size_t WS_ROPE = 5 * MiB + 65536;
constexpr size_t WS_C8 = 5 * MiB;
constexpr size_t WS_SW = 6 * MiB;
constexpr size_t WS_SUMM = 8 * MiB;
constexpr size_t WS_CARRY = 16 * MiB + 512 * 1024;
constexpr size_t WS_W = 19 * MiB;
constexpr size_t W_13 = 0, W_2 = W_13 + (size_t)2 * DFF * DM * 2, W_IN = W_2 + (size_t)DM * DFF * 2, W_GAT = W_IN + (size_t)INC * DM * 2,
                 W_BR = W_GAT + (size_t)4096 * 256 * 2, W_OUT = W_BR + (size_t)3 * DM * 1024 * 2, W_13B = W_OUT + (size_t)DM * DM * 2,
                 W_2B = W_13B + (size_t)2 * DFF * DM * 2, W_END = W_2B + (size_t)DM * DFF * 2;
constexpr size_t W_REGION = ((W_END + MiB - 1) / MiB) * MiB;
constexpr size_t WS_H = WS_W + 2 * W_REGION;
constexpr size_t WS_Z = WS_H + (size_t)MT * 4096;
constexpr size_t WS_CR = WS_Z + (size_t)MT * 13312;
constexpr size_t WS_END = WS_CR + (size_t)MT * 11264;
static_assert(WS_END <= (size_t)1418084416, "workspace map exceeds the guaranteed scratch size (sum of the inputs)");
constexpr size_t Z_ACT = 0;
constexpr size_t Z_RX = 0, Z_RG = (size_t)MT * 2048, Z_S3 = (size_t)MT * 4096, Z_Q = (size_t)MT * 10240, Z_KV = (size_t)MT * 12288;
constexpr size_t Z_LA = Z_S3;
constexpr size_t Z_UU = Z_S3 + (size_t)MT * 4096;
constexpr size_t Z_G = 0;
constexpr size_t C_UB = 0;
constexpr size_t C_XA = 0, C_YS = (size_t)MT * 2048, C_QR = (size_t)MT * 8192, C_KR = (size_t)MT * 10240, C_VT = (size_t)MT * 10752;
constexpr int CW_BAR = 4096;

__device__ __forceinline__ size_t zt(int m, int c) { return (size_t)(c >> 8) * ((size_t)MT * 256) + (size_t)m * 256 + (c & 255); }
__device__ __forceinline__ unsigned pk2(float lo, float hi) {
    typedef float f2_t __attribute__((ext_vector_type(2))); typedef __bf16 b2_t __attribute__((ext_vector_type(2)));
    f2_t v = {lo, hi}; b2_t b = __builtin_convertvector(v, b2_t); return __builtin_bit_cast(unsigned, b);
}
__device__ __forceinline__ float bflo(unsigned w) { return __uint_as_float(w << 16); }
__device__ __forceinline__ float bfhi(unsigned w) { return __uint_as_float(w & 0xffff0000u); }
__device__ __forceinline__ float wave_sum(float v) {
#pragma unroll
    for (int o = 1; o < 64; o <<= 1) v += __shfl_xor(v, o);
    return v;
}
__device__ __forceinline__ void unpack8(const u32x4 w, float (&f)[8]) { f[0] = bflo(w.x); f[1] = bfhi(w.x); f[2] = bflo(w.y); f[3] = bfhi(w.y); f[4] = bflo(w.z); f[5] = bfhi(w.z); f[6] = bflo(w.w); f[7] = bfhi(w.w); }
__device__ __forceinline__ u32x4 pack8(const float (&f)[8]) { u32x4 w; w.x = pk2(f[0], f[1]); w.y = pk2(f[2], f[3]); w.z = pk2(f[4], f[5]); w.w = pk2(f[6], f[7]); return w; }
__device__ __forceinline__ float sigmoidf_(float x) { return __builtin_amdgcn_rcpf(1.0f + __expf(-x)); }

#ifndef HALFCTX
#define HALFCTX 1
#endif
namespace pg8 {
constexpr int BM = 256, BK = 64, HALF = 128, HTB = HALF * BK * 2, STAGE_BYTES = 8 * HTB, NXCD = 8;
__host__ __device__ __forceinline__ int lds_byte(int r, int c) { const int st = (r >> 4) * 2 + (c >> 5), rr = r & 15, cc = c & 31, ob = rr * 64 + cc * 2; return st * 1024 + (ob ^ (((ob >> 9) & 1) << 5)); }
__host__ __device__ __forceinline__ void stage_rc(int b, int& R, int& C) { const int st = b / 1024, sb = b % 1024, swz = sb ^ (((sb >> 9) & 1) << 5); R = (st >> 1) * 16 + swz / 64; C = (st & 1) * 32 + (swz % 64) / 2; }
__host__ __device__ __forceinline__ int perm32(int rho) { const int n = rho >> 4, i = rho & 15; return 8 * (i >> 2) + 4 * n + (i & 3); }

struct Unit { int pm, pn; unsigned aoff, boff; int seg, keep; };
struct Gemm { const char* A; const char* Bt; int lda, ldb, K; };

struct StaticOrder {
    int nM, nN, nwg, G, c, WGM, rev;
    __host__ __device__ void init(int M, int N, int G_, int c_, int wgm = 4, int rev_ = 0) { nM = M / BM; nN = N / BM; nwg = nM * nN; G = G_; c = c_; WGM = wgm; rev = rev_; }
    __host__ __device__ int tail_start() const { const int full = (nwg / G) * G; return (HALFCTX && 2 * (nwg - full) <= G) ? full : nwg; }
    __host__ __device__ bool tile(int i, int& pm, int& pn, int lim) const {
        const long L = (long)i * G + c; if (L >= lim) return false;
        tileL((int)L, pm, pn); return true;
    }
    __host__ __device__ bool tile(int i, int& pm, int& pn) const { return tile(i, pm, pn, nwg); }
    __host__ __device__ void tileL(int L, int& pm, int& pn) const {
        int wgid = L; { const int q = nwg / NXCD, r = nwg % NXCD, xcd = wgid % NXCD, off = wgid / NXCD; wgid = (xcd < r ? xcd * (q + 1) : r * (q + 1) + (xcd - r) * q) + off; }
        const int nig = WGM * nN, gid = wgid / nig, fm = gid * WGM, gsz = (nM - fm) < WGM ? (nM - fm) : WGM;
        pm = fm + ((wgid % nig) % gsz); pn = (wgid % nig) / gsz; if (rev) pm = nM - 1 - pm;
    }
};
template <int MODE> struct Order {
    static constexpr bool QUARTER = (MODE == 3);
    StaticOrder so; int pm0;
    __device__ __forceinline__ bool next_tail(int i, Unit& u) const {
        const int L = so.tail_start() + (so.c >> 1);
        if (i > (MODE == 2 ? 2 : 0) || L >= so.nwg) return false;
        so.tileL(L, u.pm, u.pn); u.pm += pm0;
        const int h = so.c & 1;
        if (MODE == 2) { u.seg = i + 4 * (1 + h); u.keep = i < 2; u.boff = (unsigned)i * (unsigned)(DM * 1024 * 2); u.aoff = (unsigned)i * 2048u + (unsigned)(HALF * h) * (unsigned)lda2; return true; }
        u.seg = 1 + h; u.keep = 0; u.boff = 0u; u.aoff = (unsigned)(HALF * h) * (unsigned)lda2; return true;
    }
    bool ragged; int lda2;
    __device__ __forceinline__ bool next(int i, Unit& u) const {
        if (MODE == 2) { const int ti = i / 3, seg = i - 3 * ti; if (!so.tile(ti, u.pm, u.pn, so.tail_start())) return false; u.pm += pm0;
            u.aoff = (unsigned)seg * 2048u; u.boff = (unsigned)seg * (unsigned)(DM * 1024 * 2); u.seg = seg; u.keep = seg < 2; return true; }
        if (MODE == 3 && ragged) {
            if (i >= 4 || !so.tile(i, u.pm, u.pn)) return false; u.pm += 4; u.seg = 0; u.keep = 0; u.boff = 0u; u.aoff = 0u; return true;
        }
        if (!so.tile(i, u.pm, u.pn, MODE == 4 ? so.tail_start() : so.nwg)) return false; u.pm += pm0;
        u.seg = 0; u.keep = 0; u.boff = 0u; u.aoff = (MODE == 1) ? (unsigned)((u.pn & 7) * 256) : 0u; return true;
    }
};

struct OrderQ {
    int c, lda2; bool on;
    __device__ __forceinline__ bool next(int i, Unit& u) const {
        if (!on || i > 0 || c >= 128) return false;
        u.pn = c & 7; const int qi = (c >> 3) & 3; u.pm = c >> 5; u.seg = 1 + qi; u.keep = 0; u.boff = 0u; u.aoff = (unsigned)(64 * qi) * (unsigned)lda2; return true;
    }
};
template <class Epi, class Sched, int QV = 0>
__device__ __forceinline__ void gemm_phase(LAS unsigned char* lds, const Gemm g, const Sched& S, const Epi& E, const int tid) {
    const int wid = __builtin_amdgcn_readfirstlane(tid >> 6), lane = tid & 63, wr = wid >> 2, wc = wid & 3, fr = lane & 15, fq = lane >> 4;
    const int nt = g.K / BK;
    unsigned voffA[2], voffB[2];
#pragma unroll
    for (int i = 0; i < 2; ++i) { int R, C; stage_rc(tid * 16 + i * 8192, R, C); const int Rb = Epi::PERM ? ((R & ~31) + perm32(R & 31)) : R;
        voffA[i] = (unsigned)(R * g.lda + C) * 2u; voffB[i] = (unsigned)(Rb * g.ldb + C) * 2u; }
    const __amdgpu_buffer_rsrc_t rsA = __builtin_amdgcn_make_buffer_rsrc((void*)g.A, (short)0, (int)0x7fffffff, 0x00020000);
    const __amdgpu_buffer_rsrc_t rsB = __builtin_amdgcn_make_buffer_rsrc((void*)g.Bt, (short)0, (int)0x7fffffff, 0x00020000);
    const unsigned kstep = (unsigned)(BK * 2);
    const unsigned hstepA = (unsigned)HALF * (unsigned)g.lda * 2u, hstepB = (unsigned)HALF * (unsigned)g.ldb * 2u;
    const unsigned tstepA = 2u * hstepA, tstepB = 2u * hstepB;
    const unsigned ldsw = (unsigned)wid * 1024u;
    const int aoff = lds_byte(wr * 64 + fr, fq * 8), boff = lds_byte(wc * 32 + fr, fq * 8);
#define PG8_SA(b, h) (((b) * 2 + (h)) * HTB)
#define PG8_SB(b, h) ((4 + (b) * 2 + (h)) * HTB)
#define PG8_STAGEX(rs, bufoff, soff, voff) do { _Pragma("unroll") for (int _i = 0; _i < 2; ++_i) \
        __builtin_amdgcn_raw_ptr_buffer_load_lds(rs, (LAS unsigned*)(lds + (bufoff) + ldsw + _i * 8192), 16, (voff)[_i], (soff), 0, 0); } while (0)
#define PG8_LDA(dst, b, h) do { _Pragma("unroll") for (int m = 0; m < 4; ++m) _Pragma("unroll") for (int k = 0; k < 2; ++k) dst[m][k] = *(const LAS bf16x8*)(lds + PG8_SA(b, h) + aoff + m * 2048 + k * 1024); } while (0)
#define PG8_LDB(dst, b, h) do { _Pragma("unroll") for (int n = 0; n < 2; ++n) _Pragma("unroll") for (int k = 0; k < 2; ++k) dst[n][k] = *(const LAS bf16x8*)(lds + PG8_SB(b, h) + boff + n * 2048 + k * 1024); } while (0)
#define PG8_MMA(ai, bj, At, Bt) do { __builtin_amdgcn_s_setprio(1); _Pragma("unroll") for (int m = 0; m < 4; ++m) _Pragma("unroll") for (int n = 0; n < 2; ++n) _Pragma("unroll") for (int k = 0; k < 2; ++k) \
        acc[ai][bj][m][n] = Epi::SWAP ? __builtin_amdgcn_mfma_f32_16x16x32_bf16(At[m][k], Bt[n][k], acc[ai][bj][m][n], 0, 0, 0) : __builtin_amdgcn_mfma_f32_16x16x32_bf16(Bt[n][k], At[m][k], acc[ai][bj][m][n], 0, 0, 0); __builtin_amdgcn_s_setprio(0); } while (0)
#define PG8_WAIT_V(n) asm volatile("s_waitcnt vmcnt(" #n ")" ::: "memory")
#define PG8_WAIT_L(n) asm volatile("s_waitcnt lgkmcnt(" #n ")" ::: "memory")
#define PG8_BAR __builtin_amdgcn_s_barrier()
#define PG8_SCHED __builtin_amdgcn_sched_barrier(0)
    Unit cur, nxt; int ui = 0;
    if constexpr (QV == 2) { if (!S.next_tail(0, cur)) return; } else { if (!S.next(0, cur)) return; }
    f32x4 acc[2][2][4][2];
#pragma unroll
    for (int a = 0; a < 2; ++a)
#pragma unroll
        for (int b = 0; b < 2; ++b)
#pragma unroll
            for (int m = 0; m < 4; ++m)
#pragma unroll
                for (int n = 0; n < 2; ++n) { f32x2 z0, z1; asm("v_mov_b64 %0, 0\n\tv_mov_b64 %1, 0" : "=v"(z0), "=v"(z1));
                    acc[a][b][m][n] = __builtin_shufflevector(z0, z1, 0, 1, 2, 3); }
    bf16x8 At[4][2], B0[2][2], B1[2][2];
    unsigned cA = (unsigned)cur.pm * tstepA + cur.aoff, cB = (unsigned)cur.pn * tstepB + cur.boff;
    PG8_STAGEX(rsB, PG8_SB(0, 0), cB, voffB); PG8_STAGEX(rsB, PG8_SB(0, 1), cB + hstepB, voffB); PG8_STAGEX(rsA, PG8_SA(0, 0), cA, voffA); PG8_STAGEX(rsA, PG8_SA(0, 1), cA + hstepA, voffA);
    if (wr == 1) PG8_BAR;
    PG8_WAIT_V(2); PG8_BAR;
    PG8_STAGEX(rsB, PG8_SB(1, 0), cB + kstep, voffB); PG8_STAGEX(rsA, PG8_SA(1, 0), cA + kstep, voffA); PG8_STAGEX(rsB, PG8_SB(1, 1), cB + hstepB + kstep, voffB);
    PG8_WAIT_V(6); PG8_BAR;
    for (;;) {
        bool has_next; if constexpr (QV == 2) has_next = S.next_tail(ui + 1, nxt); else has_next = S.next(ui + 1, nxt);
        const unsigned nA = has_next ? (unsigned)nxt.pm * tstepA + nxt.aoff : cA, nB = has_next ? (unsigned)nxt.pn * tstepB + nxt.boff : cB;
        if constexpr (QV == 0) {
#pragma nounroll
        for (int t = 0; t < nt; t += 2) {
            const bool last = (t == nt - 2);
            const unsigned a1 = cA + (unsigned)(t + 1) * kstep;
            const unsigned a2 = last ? nA : cA + (unsigned)(t + 2) * kstep, b2 = last ? nB : cB + (unsigned)(t + 2) * kstep;
            const unsigned a3 = a2 + kstep, b3 = b2 + kstep;
            PG8_LDB(B0, 0, 0); PG8_LDB(B1, 0, 1); PG8_SCHED; PG8_LDA(At, 0, 0); PG8_STAGEX(rsA, PG8_SA(1, 1), a1 + hstepA, voffA);
            PG8_WAIT_V(8); PG8_WAIT_L(0); PG8_BAR; PG8_MMA(0, 0, At, B0); PG8_MMA(0, 1, At, B1); PG8_BAR; PG8_SCHED;
            PG8_LDA(At, 0, 1); PG8_STAGEX(rsB, PG8_SB(0, 0), b2, voffB); PG8_STAGEX(rsB, PG8_SB(0, 1), b2 + hstepB, voffB); PG8_STAGEX(rsA, PG8_SA(0, 0), a2, voffA);
            PG8_WAIT_V(8); PG8_WAIT_L(0); PG8_BAR; PG8_MMA(1, 0, At, B0); PG8_MMA(1, 1, At, B1); PG8_BAR; PG8_SCHED;
            PG8_LDB(B0, 1, 0); PG8_LDB(B1, 1, 1); PG8_SCHED; PG8_LDA(At, 1, 0); PG8_STAGEX(rsA, PG8_SA(0, 1), a2 + hstepA, voffA);
            PG8_WAIT_V(8); PG8_WAIT_L(0); PG8_BAR; PG8_MMA(0, 0, At, B0); PG8_MMA(0, 1, At, B1); PG8_BAR; PG8_SCHED;
            PG8_LDA(At, 1, 1); PG8_STAGEX(rsB, PG8_SB(1, 0), b3, voffB); PG8_STAGEX(rsB, PG8_SB(1, 1), b3 + hstepB, voffB); PG8_STAGEX(rsA, PG8_SA(1, 0), a3, voffA);
            PG8_WAIT_V(8); PG8_WAIT_L(0); PG8_BAR; PG8_MMA(1, 0, At, B0); PG8_MMA(1, 1, At, B1); PG8_BAR; PG8_SCHED;
        }
        } else {
            const bool w0 = (QV == 2) || (wr == 0);
#pragma nounroll
            for (int t = 0; t < nt; t += 2) {
                const bool last = (t == nt - 2);
                const unsigned a1 = cA + (unsigned)(t + 1) * kstep;
                const unsigned a2 = last ? nA : cA + (unsigned)(t + 2) * kstep, b2 = last ? nB : cB + (unsigned)(t + 2) * kstep;
                const unsigned a3 = a2 + kstep, b3 = b2 + kstep;
                if (w0) { PG8_LDB(B0, 0, 0); PG8_LDB(B1, 0, 1); PG8_SCHED; PG8_LDA(At, 0, 0); }
                PG8_WAIT_L(0); PG8_BAR; if (w0) { PG8_MMA(0, 0, At, B0); PG8_MMA(0, 1, At, B1); } PG8_BAR; PG8_SCHED;
                PG8_STAGEX(rsB, PG8_SB(0, 0), b2, voffB); PG8_STAGEX(rsB, PG8_SB(0, 1), b2 + hstepB, voffB); PG8_STAGEX(rsA, PG8_SA(0, 0), a2, voffA);
                PG8_WAIT_V(6); PG8_BAR; PG8_BAR; PG8_SCHED;
                if (w0) { PG8_LDB(B0, 1, 0); PG8_LDB(B1, 1, 1); PG8_SCHED; PG8_LDA(At, 1, 0); }
                PG8_WAIT_L(0); PG8_BAR; if (w0) { PG8_MMA(0, 0, At, B0); PG8_MMA(0, 1, At, B1); } PG8_BAR; PG8_SCHED;
                PG8_STAGEX(rsB, PG8_SB(1, 0), b3, voffB); PG8_STAGEX(rsB, PG8_SB(1, 1), b3 + hstepB, voffB); PG8_STAGEX(rsA, PG8_SA(1, 0), a3, voffA);
                PG8_WAIT_V(6); PG8_BAR; PG8_BAR; PG8_SCHED;
            }
        }
        if (wr == 0) PG8_BAR;
        E.template run<QV>(acc, cur, wr, wc, fr, fq);
        if (!has_next) break;
        if (!cur.keep) {
#pragma unroll
            for (int a = 0; a < 2; ++a)
#pragma unroll
                for (int b = 0; b < 2; ++b)
#pragma unroll
                    for (int m = 0; m < 4; ++m)
#pragma unroll
                        for (int n = 0; n < 2; ++n) { f32x2 z0, z1; asm("v_mov_b64 %0, 0\n\tv_mov_b64 %1, 0" : "=v"(z0), "=v"(z1));
                    acc[a][b][m][n] = __builtin_shufflevector(z0, z1, 0, 1, 2, 3); }
        }
        cur = nxt; cA = nA; cB = nB; ++ui;
        if (wr == 1) PG8_BAR;
    }
    PG8_WAIT_V(0);
    PG8_BAR;
#undef PG8_SA
#undef PG8_SB
#undef PG8_STAGEX
#undef PG8_LDA
#undef PG8_LDB
#undef PG8_MMA
#undef PG8_WAIT_V
#undef PG8_WAIT_L
#undef PG8_BAR
#undef PG8_SCHED
}

constexpr float SSQ_SCALE = 1048576.0f;
__device__ __forceinline__ void row_rstd(const unsigned long long* ssq, int row0, float (&rs)[2][4]) {
    unsigned long long q[2][4];
#pragma unroll
    for (int ai = 0; ai < 2; ++ai)
#pragma unroll
        for (int m = 0; m < 4; ++m) q[ai][m] = ssq[row0 + ai * HALF + m * 16];
    asm volatile("" : "+v"(q[0][0]), "+v"(q[0][1]), "+v"(q[0][2]), "+v"(q[0][3]), "+v"(q[1][0]), "+v"(q[1][1]), "+v"(q[1][2]), "+v"(q[1][3]));
#pragma unroll
    for (int ai = 0; ai < 2; ++ai)
#pragma unroll
        for (int m = 0; m < 4; ++m) {
            const float qf = __builtin_fmaf((float)(unsigned)(q[ai][m] >> 32), 4294967296.0f, (float)(unsigned)q[ai][m]);
            rs[ai][m] = __builtin_amdgcn_rsqf(__builtin_fmaf(qf, 1.0f / (SSQ_SCALE * DM), EPS)); }
}
struct EpiStore {
    static constexpr bool PERM = true; static constexpr bool SWAP = false;
    bf16_t* O; int ld; size_t tstride; const unsigned long long* ssq; const float* sw;
    bf16_t* QR; bf16_t* KR; const float* rope;
    bf16_t* XA; const float* cw; const float* cbi;
    template <int QVV> __device__ __forceinline__ void run(f32x4 (&acc)[2][2][4][2], const Unit& u, int wr, int wc, int fr, int fq) const {
        constexpr int nai = (QVV == 2) ? 1 : 2; const int r0 = u.pm * BM + (QVV == 2 ? (u.seg - 1) * HALF : 0);
        char* tb = (char*)(O + (size_t)u.pn * tstride + (size_t)r0 * ld);
        const int v = u.pm < 4 ? 4 : ((u.pm - 4) >> 5);
        const char* swb = (const char*)(sw + (size_t)v * SWLD + u.pn * BM);
        unsigned lo = (unsigned)((wr * 64 + fr) * ld + wc * 32 + 8 * fq) * 2u;
        unsigned co = (unsigned)(wc * 32 + 8 * fq) * 4u;
        const unsigned rs_ = (unsigned)ld * 2u;
        asm volatile("" : "+v"(lo), "+v"(co));
        float rs[2][4]; row_rstd(ssq, r0 + wr * 64 + fr, rs);
        if (u.pn < 4) {
            const int c0 = u.pn * BM + wc * 32 + 8 * fq;
#pragma unroll
            for (int bj = 0; bj < 2; ++bj) {
                const f32x4 sh[2] = {*(const f32x4*)(swb + co + bj * HALF * 4), *(const f32x4*)(swb + co + bj * HALF * 4 + 16)};
                const float* cwp = cw + c0 + bj * HALF; const float* cbp = cbi + c0 + bj * HALF;
#pragma unroll
                for (int ai = 0; ai < 2; ++ai) { if (ai >= nai) continue;
#pragma unroll
                    for (int n = 0; n < 2; ++n) {
                        const f32x4 w0 = *(const f32x4*)(cwp + 4 * n), w1 = *(const f32x4*)(cwp + 1024 + 4 * n), w2 = *(const f32x4*)(cwp + 2048 + 4 * n), w3 = *(const f32x4*)(cwp + 3072 + 4 * n), bb = *(const f32x4*)(cbp + 4 * n);
                        f32x4 X[4];
#pragma unroll
                        for (int m = 0; m < 4; ++m) X[m] = acc[ai][bj][m][n] * rs[ai][m] + sh[n];
                        if (fr <= 2) *(u32x2*)(tb + lo + (unsigned)(ai * HALF) * rs_ + bj * HALF * 2 + n * 8) = (u32x2){pk2(X[0][0], X[0][1]), pk2(X[0][2], X[0][3])};
                        if (fr >= 13) *(u32x2*)(tb + lo + (unsigned)(ai * HALF + 48) * rs_ + bj * HALF * 2 + n * 8) = (u32x2){pk2(X[3][0], X[3][1]), pk2(X[3][2], X[3][3])};
#pragma unroll
                        for (int m = 0; m < 4; ++m) {
                            const int mp = m > 0 ? m - 1 : 0, mn = m < 3 ? m + 1 : 3;
                            f32x4 o;
#pragma unroll
                            for (int i = 0; i < 4; ++i) {
                                const float xif = X[m][i], xpf = X[mp][i], xnf = X[mn][i];
                                const int xi = __float_as_int(xif), xp = __float_as_int(xpf), xn = __float_as_int(xnf);
                                const float p1 = __builtin_bit_cast(float, __builtin_amdgcn_update_dpp(__builtin_amdgcn_update_dpp(0, xp, 0x121, 0xf, 0xf, false), xi, 0x111, 0xf, 0xf, false));
                                const float p2 = __builtin_bit_cast(float, __builtin_amdgcn_update_dpp(__builtin_amdgcn_update_dpp(0, xp, 0x122, 0xf, 0xf, false), xi, 0x112, 0xf, 0xf, false));
                                const float n1 = __builtin_bit_cast(float, __builtin_amdgcn_update_dpp(__builtin_amdgcn_update_dpp(0, xn, 0x12f, 0xf, 0xf, false), xi, 0x101, 0xf, 0xf, false));
                                o[i] = bb[i] + w0[i] * p2 + w1[i] * p1 + w2[i] * X[m][i] + w3[i] * n1; }
                            const int r = r0 + wr * 64 + fr + ai * HALF + m * 16;
                            const bool edge = (m == 0 && fr < 2) || (m == 3 && fr == 15);
                            if (!edge) *(u32x2*)(XA + (size_t)r * 1024 + c0 + bj * HALF + 4 * n) = (u32x2){pk2(o[0], o[1]), pk2(o[2], o[3])}; }
                    }
                }
            }
            return;
        }
        if (u.pn >= 12 && u.pn < 20) {
            const int j = u.pn - 12;
            char* tp = (char*)(O + (size_t)(12 + (j >> 1)) * tstride + (size_t)r0 * ld) + (j & 1) * 256;
            const f32x4 a0 = *(const f32x4*)(swb + co), a1 = *(const f32x4*)(swb + co + 16), b0 = *(const f32x4*)(swb + co + HALF * 4), b1 = *(const f32x4*)(swb + co + HALF * 4 + 16);
#pragma unroll
            for (int ai = 0; ai < 2; ++ai)
#pragma unroll
                for (int m = 0; m < 4; ++m) { if (ai >= nai) continue; const unsigned ro = lo + (unsigned)(ai * HALF + m * 16) * rs_;
                    const f32x4 v0 = (acc[ai][0][m][0] * rs[ai][m] + a0) * (acc[ai][1][m][0] * rs[ai][m] + b0), v1 = (acc[ai][0][m][1] * rs[ai][m] + a1) * (acc[ai][1][m][1] * rs[ai][m] + b1);
                    u32x4 w; w.x = pk2(v0[0], v0[1]); w.y = pk2(v0[2], v0[3]); w.z = pk2(v1[0], v1[1]); w.w = pk2(v1[2], v1[3]);
                    *(u32x4*)(tp + ro) = w; }
            return;
        }
        if (u.pn >= 20 && u.pn < 25) {
            const int j = u.pn - 20, sa = wc & 1; const bool isk = (j == 4), ctx = u.pm < 4;
            bf16_t* ob = isk ? KR : QR; const int ldo = isk ? 256 : 1024;
            unsigned oo = (unsigned)((isk ? (wc >> 1) : 2 * j + (wc >> 1)) * 128 + sa * 64 + 8 * fq);
            asm volatile("" : "+v"(oo));
            const f32x4 a0 = *(const f32x4*)(swb + co), a1 = *(const f32x4*)(swb + co + 16), b0 = *(const f32x4*)(swb + co + HALF * 4), b1 = *(const f32x4*)(swb + co + HALF * 4 + 16);
#pragma unroll
            for (int ai = 0; ai < 2; ++ai)
#pragma unroll
                for (int m = 0; m < 4; ++m) { if (ai >= nai) continue;
                    const int r = r0 + wr * 64 + fr + ai * HALF + m * 16;
                    f32x4 c0 = {1.f, 1.f, 1.f, 1.f}, c1 = c0, s0 = {0.f, 0.f, 0.f, 0.f}, s1 = s0;
                    if (!ctx) { const int t = (r - MC) & 8191, pos = sa ? (t & 63) : (t >> 6); const float* tp = rope + pos * 32 + 8 * fq;
                        c0 = *(const f32x4*)tp; c1 = *(const f32x4*)(tp + 4); s0 = *(const f32x4*)(tp + 4096); s1 = *(const f32x4*)(tp + 4100); }
                    const f32x4 x10 = acc[ai][0][m][0] * rs[ai][m] + a0, x11 = acc[ai][0][m][1] * rs[ai][m] + a1, x20 = acc[ai][1][m][0] * rs[ai][m] + b0, x21 = acc[ai][1][m][1] * rs[ai][m] + b1;
                    const f32x4 p0 = x10 * c0 - x20 * s0, p1 = x11 * c1 - x21 * s1, q0 = x20 * c0 + x10 * s0, q1 = x21 * c1 + x11 * s1;
                    u32x4 w1, w2; w1.x = pk2(p0[0], p0[1]); w1.y = pk2(p0[2], p0[3]); w1.z = pk2(p1[0], p1[1]); w1.w = pk2(p1[2], p1[3]);
                    w2.x = pk2(q0[0], q0[1]); w2.y = pk2(q0[2], q0[3]); w2.z = pk2(q1[0], q1[1]); w2.w = pk2(q1[2], q1[3]);
                    bf16_t* op = ob + (size_t)r * ldo + oo;
                    *(u32x4*)op = w1; *(u32x4*)(op + 32) = w2; }
            return;
        }
#pragma unroll
        for (int bj = 0; bj < 2; ++bj) { const f32x4 s0 = *(const f32x4*)(swb + co + bj * HALF * 4), s1 = *(const f32x4*)(swb + co + bj * HALF * 4 + 16);
#pragma unroll
            for (int ai = 0; ai < 2; ++ai)
#pragma unroll
                for (int m = 0; m < 4; ++m) { if (ai >= nai) continue; const unsigned ro = lo + (unsigned)(ai * HALF + m * 16) * rs_;
                    const f32x4 v0 = acc[ai][bj][m][0] * rs[ai][m] + s0, v1 = acc[ai][bj][m][1] * rs[ai][m] + s1;
                    u32x4 w; w.x = pk2(v0[0], v0[1]); w.y = pk2(v0[2], v0[3]); w.z = pk2(v1[0], v1[1]); w.w = pk2(v1[2], v1[3]);
                    *(u32x4*)(tb + ro + bj * HALF * 2) = w; } }
    }
};
struct EpiSwiglu {
    static constexpr bool PERM = true; static constexpr bool SWAP = false;
    bf16_t* O; const unsigned long long* ssq; const float* sw;
    template <int QVV> __device__ __forceinline__ void run(f32x4 (&acc)[2][2][4][2], const Unit& u, int wr, int wc, int fr, int fq) const {
        constexpr int nai = (QVV == 2) ? 1 : 2; const int r0 = u.pm * BM + (QVV == 2 ? (u.seg - 1) * HALF : 0);
        char* tb = (char*)(O + (size_t)r0 * DFF + u.pn * HALF);
        const int v = u.pm < 4 ? 4 : ((u.pm - 4) >> 5);
        const char* swb = (const char*)(sw + (size_t)v * SWLD + u.pn * BM);
        unsigned lo = (unsigned)((wr * 64 + fr) * DFF + wc * 32 + 8 * fq) * 2u;
        unsigned co = (unsigned)(wc * 32 + 8 * fq) * 4u;
        asm volatile("" : "+v"(lo), "+v"(co));
        float rs[2][4]; row_rstd(ssq, r0 + wr * 64 + fr, rs);
        f32x4 sg[2], su[2], sgn[2];
#pragma unroll
        for (int n = 0; n < 2; ++n) { sg[n] = *(const f32x4*)(swb + co + n * 16); su[n] = *(const f32x4*)(swb + co + HALF * 4 + n * 16); sgn[n] = sg[n] * (-LOG2E); }
#pragma unroll
        for (int ai = 0; ai < 2; ++ai)
#pragma unroll
            for (int m = 0; m < 4; ++m) { if (ai >= nai) continue;
                const float r = rs[ai][m], rn = r * (-LOG2E);
                f32x4 o[2];
#pragma unroll
                for (int n = 0; n < 2; ++n) {
                    const f32x4 gt = acc[ai][0][m][n] * r + sg[n], up = acc[ai][1][m][n] * r + su[n], ex = acc[ai][0][m][n] * rn + sgn[n];
                    f32x4 den, rc;
#pragma unroll
                    for (int i = 0; i < 4; ++i) den[i] = __builtin_amdgcn_exp2f(ex[i]);
                    den = den + 1.0f;
#pragma unroll
                    for (int i = 0; i < 4; ++i) rc[i] = __builtin_amdgcn_rcpf(den[i]);
                    o[n] = (gt * up) * rc; }
                u32x4 w; w.x = pk2(o[0][0], o[0][1]); w.y = pk2(o[0][2], o[0][3]); w.z = pk2(o[1][0], o[1][1]); w.w = pk2(o[1][2], o[1][3]);
                *(u32x4*)(tb + lo + (unsigned)(ai * HALF + m * 16) * (DFF * 2)) = w; }
    }
};
struct EpiResid {
    static constexpr bool PERM = true; static constexpr bool SWAP = false;
    bf16_t* S; const float* gate;
    const float* pg; const float* psc; const float* ng; const float* nsc; unsigned long long* ssq;
    float fac;
    template <int QVV> __device__ __forceinline__ void run(f32x4 (&acc)[2][2][4][2], const Unit& u, int wr, int wc, int fr, int fq) const {
        const bool qm = u.seg != 0; const int rq = qm ? 64 * (u.seg - 1) : 0;
        const bool active = !(qm && wr == 1);
        const int v = u.pm < 4 ? 4 : ((u.pm - 4) >> 5);
        char* sb = (char*)(S + ((size_t)u.pm * BM + rq) * DM + u.pn * BM);
        const char* gp = (const char*)(gate + (size_t)v * (NMOD * DM) + u.pn * BM);
        const bool hasn = ng != nullptr;
        const char* pgp = (const char*)(pg + u.pn * BM); const char* psp = (const char*)(psc + (size_t)v * (NMOD * DM) + u.pn * BM);
        const char* ngp = (const char*)(ng + u.pn * BM); const char* nsp = (const char*)(nsc + (size_t)v * (NMOD * DM) + u.pn * BM);
        unsigned co = (unsigned)(wc * 32 + 8 * fq);
        asm volatile("" : "+v"(co));
        unsigned lo = ((unsigned)((wr * 64 + fr) * DM) + co) * 2u;
        asm volatile("" : "+v"(lo));
        if (active) {
        float ss[2][4];
#pragma unroll
        for (int ai = 0; ai < 2; ++ai)
#pragma unroll
            for (int m = 0; m < 4; ++m) ss[ai][m] = 0.f;
#pragma unroll
        for (int bj = 0; bj < 2; ++bj) {
            const unsigned cb4 = (co + bj * HALF) * 4u;
            f32x4 vg0 = *(const f32x4*)(gp + cb4), vg1 = *(const f32x4*)(gp + cb4 + 16), vp0 = *(const f32x4*)(pgp + cb4), vp1 = *(const f32x4*)(pgp + cb4 + 16), vs0 = *(const f32x4*)(psp + cb4), vs1 = *(const f32x4*)(psp + cb4 + 16);
            f32x4 vn0 = {1.f, 1.f, 1.f, 1.f}, vn1 = vn0, vt0 = {0.f, 0.f, 0.f, 0.f}, vt1 = vt0;
            if (hasn) { vn0 = *(const f32x4*)(ngp + cb4); vn1 = *(const f32x4*)(ngp + cb4 + 16); vt0 = *(const f32x4*)(nsp + cb4); vt1 = *(const f32x4*)(nsp + cb4 + 16); }
            asm volatile("" : "+v"(vg0), "+v"(vg1), "+v"(vp0), "+v"(vp1), "+v"(vs0), "+v"(vs1), "+v"(vn0), "+v"(vn1), "+v"(vt0), "+v"(vt1));
            const f32x4 g0 = vg0 * fac, g1 = vg1 * fac;
            const f32x4 p0 = vp0 * (vs0 + 1.0f), p1 = vp1 * (vs1 + 1.0f);
            f32x4 r0, r1;
#pragma unroll
            for (int i = 0; i < 4; ++i) { r0[i] = __builtin_amdgcn_rcpf(p0[i]); r1[i] = __builtin_amdgcn_rcpf(p1[i]); }
            const f32x4 c0 = vn0 * (vt0 + 1.0f), c1 = vn1 * (vt1 + 1.0f);
            u32x4 hin[2][4];
#pragma unroll
            for (int ai = 0; ai < 2; ++ai)
#pragma unroll
                for (int m = 0; m < 4; ++m) { if (ai == 1 && qm) continue; hin[ai][m] = *(const u32x4*)(sb + lo + (unsigned)((ai * HALF + m * 16) * DM + bj * HALF) * 2u); }
#pragma unroll
            for (int ai = 0; ai < 2; ++ai)
#pragma unroll
                for (int m = 0; m < 4; ++m) { if (ai == 1 && qm) continue;
                    const unsigned off = lo + (unsigned)((ai * HALF + m * 16) * DM + bj * HALF) * 2u;
                    float hv[8]; unpack8(hin[ai][m], hv);
                    float y[8]; float t = 0.f;
#pragma unroll
                    for (int i = 0; i < 4; ++i) { const float a0 = hv[i] * r0[i] + g0[i] * acc[ai][bj][m][0][i], a1 = hv[4 + i] * r1[i] + g1[i] * acc[ai][bj][m][1][i];
                        t += a0 * a0 + a1 * a1; y[i] = a0 * c0[i]; y[4 + i] = a1 * c1[i]; }
                    ss[ai][m] += t;
                    *(u32x4*)(sb + off) = pack8(y); }
            asm volatile("" ::: "memory");
        }
        if (hasn) {
            unsigned long long* sp = ssq + u.pm * BM + rq + wr * 64 + fr;
#pragma unroll
            for (int ai = 0; ai < 2; ++ai)
#pragma unroll
                for (int m = 0; m < 4; ++m) { if (ai == 1 && qm) continue; float t = ss[ai][m]; t += __shfl_xor(t, 16); t += __shfl_xor(t, 32);
                    const float xs = t * SSQ_SCALE; const unsigned xh = (unsigned)(xs * 2.3283064365386963e-10f), xl = (unsigned)__builtin_fmaf(-(float)xh, 4294967296.0f, xs);
                    if (fq == 0) atomicAdd(sp + ai * HALF + m * 16, ((unsigned long long)xh << 32) | xl); }
        }
        }
    }
};
struct EpiGates {
    static constexpr bool PERM = false; static constexpr bool SWAP = true;
    const bf16_t* XA; unsigned* LU; f32x2* SMH;
    const float *ba, *bx, *c8;
    template <int QVV> __device__ __forceinline__ void run(f32x4 (&acc)[2][2][4][2], const Unit& u, int wr, int wc, int fr, int fq) const {
        const int d = u.pn >> 3, q = u.pn & 7;
        const char* xb = (const char*)(XA + (size_t)u.pm * BM * 1024 + q * HALF);
        char* lb = (char*)(LU + ((size_t)(d * 1024 + q * HALF)) * MT + (size_t)u.pm * BM);
        unsigned cl = (unsigned)(wc * 32 + fr), tl = (unsigned)(wr * 64 + 4 * fq);
        asm volatile("" : "+v"(cl), "+v"(tl));
        const float* bb = ba + d * 1024 + q * HALF; const float* xbb = bx + d * 1024 + q * HALF; const float* cbb = c8 + d * 1024 + q * HALF;
        unsigned short xw[2][2][4][4];
#pragma unroll
        for (int n = 0; n < 2; ++n)
#pragma unroll
            for (int ai = 0; ai < 2; ++ai)
#pragma unroll
                for (int m = 0; m < 4; ++m)
#pragma unroll
                    for (int i = 0; i < 4; ++i) xw[n][ai][m][i] = *(const unsigned short*)(xb + ((tl + (unsigned)(ai * HALF + m * 16 + i)) * 1024u + cl + 16u * n) * 2u);
        const int lane_hi = fq;
#pragma unroll
        for (int n = 0; n < 2; ++n) {
            const unsigned ch = cl + 16u * n;
            const float bavn = bb[ch] * (-LOG2E), bxvn = xbb[ch] * (-LOG2E), c8l = cbb[ch] * LOG2E;
#pragma unroll
            for (int ai = 0; ai < 2; ++ai) {
                float Pm[4], Hm[4];
#pragma unroll
                for (int m = 0; m < 4; ++m) {
                    unsigned w[4]; float av[4], uv[4];
#pragma unroll
                    for (int i = 0; i < 4; ++i) {
                        const float er = 1.0f + __builtin_amdgcn_exp2f(__builtin_fmaf(acc[ai][0][m][n][i], -LOG2E, bavn)), ei = 1.0f + __builtin_amdgcn_exp2f(__builtin_fmaf(acc[ai][1][m][n][i], -LOG2E, bxvn));
                        const float rr = __builtin_amdgcn_rcpf(er * ei), rgt = rr * ei, igt = rr * er;
                        const float l2 = c8l * rgt;
                        const float a1 = __builtin_amdgcn_exp2f(__uint_as_float(pk2(l2, 0.f) << 16));
                        const float mult = __builtin_amdgcn_sqrtf(fmaxf(__builtin_fmaf(-a1, a1, 1.0f), 0.0f));
                        w[i] = pk2(l2, mult * igt * __uint_as_float((unsigned)xw[n][ai][m][i] << 16));
                        av[i] = a1; uv[i] = __uint_as_float(w[i] & 0xffff0000u);
                    }
                    *(u32x4*)(lb + ((size_t)ch * MT + tl + (unsigned)(ai * HALF + m * 16)) * 4u) = (u32x4){w[0], w[1], w[2], w[3]};
                    float P = 1.f, H = 0.f;
                    if (d == 0) {
#pragma unroll
                        for (int i = 0; i < 4; ++i) { H = av[i] * H + uv[i]; P *= av[i]; }
                    } else {
#pragma unroll
                        for (int i = 3; i >= 0; --i) { H = av[i] * H + uv[i]; P *= av[i]; }
                    }
#pragma unroll
                    for (int sft = 16; sft < 64; sft <<= 1) {
                        const float Pq = __shfl_xor(P, sft), Hq = __shfl_xor(H, sft);
                        const bool lowhalf = ((lane_hi * 16) & sft) == 0;
                        const bool mine_first = (d == 0) ? lowhalf : !lowhalf;
                        const float Px = mine_first ? P : Pq, Hx = mine_first ? H : Hq, Py = mine_first ? Pq : P, Hy = mine_first ? Hq : H;
                        P = Px * Py; H = Py * Hx + Hy;
                    }
                    Pm[m] = P; Hm[m] = H;
                }
                float P = 1.f, H = 0.f;
                if (d == 0) {
#pragma unroll
                    for (int m = 0; m < 4; ++m) { H = Pm[m] * H + Hm[m]; P *= Pm[m]; }
                } else {
#pragma unroll
                    for (int m = 3; m >= 0; --m) { H = Pm[m] * H + Hm[m]; P *= Pm[m]; }
                }
                if (fq == 0) SMH[((size_t)d * 528 + (size_t)(u.pm * 4 + 2 * ai + wr)) * 1024 + q * HALF + ch] = (f32x2){P, H};
            }
        }
    }
};
struct EpiGate8 {
    static constexpr bool PERM = true; static constexpr bool SWAP = false;
    unsigned char* O; const unsigned long long* ssq; const float* sw; const float* bm;
    template <int QVV> __device__ __forceinline__ void run(f32x4 (&acc)[2][2][4][2], const Unit& u, int wr, int wc, int fr, int fq) const {
        constexpr int nai = (QVV == 2) ? 1 : 2; const int r0 = u.pm * BM + (QVV == 2 ? (u.seg - 1) * HALF : 0);
        char* tb = (char*)(O + (size_t)r0 * NGC + u.pn * BM);
        const int v = u.pm < 4 ? 4 : ((u.pm - 4) >> 5);
        const char* swb = (const char*)(sw + (size_t)v * SWLD + u.pn * BM); const char* bmb = (const char*)(bm + u.pn * BM);
        unsigned lo = (unsigned)((wr * 64 + fr) * NGC + wc * 32 + 8 * fq);
        unsigned co = (unsigned)(wc * 32 + 8 * fq) * 4u;
        asm volatile("" : "+v"(lo), "+v"(co));
        float rs[2][4]; row_rstd(ssq, r0 + wr * 64 + fr, rs);
#pragma unroll
        for (int bj = 0; bj < 2; ++bj) {
            const f32x4 s0 = (*(const f32x4*)(swb + co + bj * HALF * 4) + *(const f32x4*)(bmb + co + bj * HALF * 4)) * (-LOG2E) - 7.994353436858858f,
                        s1 = (*(const f32x4*)(swb + co + bj * HALF * 4 + 16) + *(const f32x4*)(bmb + co + bj * HALF * 4 + 16)) * (-LOG2E) - 7.994353436858858f;
#pragma unroll
            for (int ai = 0; ai < 2; ++ai)
#pragma unroll
                for (int m = 0; m < 4; ++m) { if (ai >= nai) continue;
                    const float rn = rs[ai][m] * (-LOG2E);
                    const f32x4 x0 = acc[ai][bj][m][0] * rn + s0, x1 = acc[ai][bj][m][1] * rn + s1;
                    f32x4 d0, d1;
#pragma unroll
                    for (int i = 0; i < 4; ++i) { d0[i] = __builtin_amdgcn_exp2f(x0[i]); d1[i] = __builtin_amdgcn_exp2f(x1[i]); }
                    d0 = d0 + (1.0f / 255.0f); d1 = d1 + (1.0f / 255.0f);
                    u32x2 w = {0u, 0u};
#pragma unroll
                    for (int i = 0; i < 4; ++i) { const float g0 = fmaxf(__builtin_amdgcn_rcpf(d0[i]), 1.0f), g1 = fmaxf(__builtin_amdgcn_rcpf(d1[i]), 1.0f);
                        w.x = __builtin_amdgcn_cvt_pk_u8_f32(g0, i, w.x); w.y = __builtin_amdgcn_cvt_pk_u8_f32(g1, i, w.y); }
                    *(u32x2*)(tb + lo + (unsigned)((ai * HALF + m * 16) * NGC + bj * HALF)) = w; }
        }
    }
};
struct EpiMerge {
    static constexpr bool PERM = true; static constexpr bool SWAP = false;
    const unsigned char* G; bf16_t* O;
    template <int QVV> __device__ __forceinline__ void run(f32x4 (&acc)[2][2][4][2], const Unit& u, int wr, int wc, int fr, int fq) const {
        const int s = u.seg & 3, s1 = s < 2 ? s + 1 : s, hh = u.seg >> 2, r0 = u.pm * BM + (QVV == 2 ? (hh - 1) * HALF : 0); constexpr int nai = (QVV == 2) ? 1 : 2;
        const char* g0b = (const char*)(G + (size_t)r0 * NGC + s * DM + u.pn * BM); const char* g1b = (const char*)(G + (size_t)r0 * NGC + s1 * DM + u.pn * BM);
        char* ob = (char*)(O + (size_t)r0 * DM + u.pn * BM);
        unsigned co = (unsigned)(wc * 32 + 8 * fq);
        asm volatile("" : "+v"(co));
        unsigned lg = (unsigned)((wr * 64 + fr) * NGC) + co, lw = ((unsigned)((wr * 64 + fr) * DM) + co) * 2u;
        asm volatile("" : "+v"(lg), "+v"(lw));
        const bool last = (s == 2);
        const unsigned lm = last ? 0xffffffffu : 0u;
#pragma unroll
        for (int bj = 0; bj < 2; ++bj) {
            u32x2 g0v[2][4], g1v[2][4];
#pragma unroll
            for (int ai = 0; ai < 2; ++ai)
#pragma unroll
                for (int m = 0; m < 4; ++m) { if (ai >= nai) continue; const unsigned rr = (unsigned)(ai * HALF + m * 16);
                    g0v[ai][m] = *(const u32x2*)(g0b + lg + rr * NGC + bj * HALF); g1v[ai][m] = *(const u32x2*)(g1b + lg + rr * NGC + bj * HALF); }
#pragma unroll
            for (int ai = 0; ai < 2; ++ai)
#pragma unroll
                for (int m = 0; m < 4; ++m) { if (ai >= nai) continue; const unsigned rr = (unsigned)(ai * HALF + m * 16);
                    float o[8];
#pragma unroll
                    for (int n = 0; n < 2; ++n)
#pragma unroll
                        for (int i = 0; i < 4; ++i) {
                            const unsigned w0 = n == 0 ? g0v[ai][m].x : g0v[ai][m].y, w1 = (n == 0 ? g1v[ai][m].x : g1v[ai][m].y) | lm;
                            const float q0 = (float)((w0 >> (8 * i)) & 255u), q1 = (float)((w1 >> (8 * i)) & 255u);
                            const float f = q0 * __builtin_amdgcn_rcpf(q1);
                            const float v = acc[ai][bj][m][n][i] * f; acc[ai][bj][m][n][i] = v; o[n * 4 + i] = v; }
                    if (last) { u32x4 w; w.x = pk2(o[0], o[1]); w.y = pk2(o[2], o[3]); w.z = pk2(o[4], o[5]); w.w = pk2(o[6], o[7]);
                        *(u32x4*)(ob + lw + (rr * DM + bj * HALF) * 2u) = w; } }
            asm volatile("" ::: "memory");
        }
    }
};
}

constexpr int RING_BYTES = 131072;
constexpr int LDSCTL_OFF = RING_BYTES, MISC_OFF = LDSCTL_OFF + 320;
constexpr int LDS_BYTES = 147456;
constexpr int NWAVES = 8;
#ifndef REVMASK
#define REVMASK 0xA2
#endif
#ifndef S2REV
#define S2REV 0
#endif
#ifndef FINREV
#define FINREV 0
#endif
#ifndef REVLAYER
#define REVLAYER 1
#endif
#ifndef WGMCFG
#define WGMCFG 0x444444
#endif
#define WGM_G1 ((WGMCFG >> 20) & 15)
#define WGM_G2 ((WGMCFG >> 16) & 15)
#define WGM_G3 ((WGMCFG >> 12) & 15)
#define WGM_G4 ((WGMCFG >> 8) & 15)
#define WGM_G5 ((WGMCFG >> 4) & 15)
#define WGM_GA (WGMCFG & 15)

typedef GAS unsigned gu32;
#define RLX_AGENT __ATOMIC_RELAXED, __HIP_MEMORY_SCOPE_AGENT
#define LDS_WAIT() asm volatile("s_waitcnt lgkmcnt(0)" ::: "memory")

#define XB_TMO      128
#define XB_XCNT(j)  (256  + 64 * (j))
#define XB_XSUB(j)  (1280 + 64 * (j))
#define XB_XGEN(j)  (2304 + 64 * (j))
#define XB_TOP      3328
#define XB_TOPGEN   3392
#define XCD_BAR_WORDS 3456
#define XB_SPIN_CAP (1u << 18)
__device__ __forceinline__ unsigned xb_ld(unsigned* p)              { return __hip_atomic_load(p, __ATOMIC_RELAXED, __HIP_MEMORY_SCOPE_AGENT); }
__device__ __forceinline__ unsigned xb_add(unsigned* p, unsigned v) { return __hip_atomic_fetch_add(p, v, __ATOMIC_RELAXED, __HIP_MEMORY_SCOPE_AGENT); }
__device__ __forceinline__ unsigned xb_xcc_id() { return (unsigned)__builtin_amdgcn_s_getreg((3 << 11) | 20) & 0xFu; }
#define XB_SPIN(cond, bar) do { unsigned _sp = 0; while (cond) { __builtin_amdgcn_s_sleep(1); \
    if ((++_sp & 255u) == 0u) { if (xb_ld(&(bar)[XB_TMO])) break; if (_sp > XB_SPIN_CAP) { atomicAdd(&(bar)[XB_TMO], 1u); break; } } } } while (0)
struct XcdBarrier { unsigned* bar; unsigned x; volatile LAS unsigned* st; };
__device__ __forceinline__ XcdBarrier xcd_barrier_post(unsigned* bar, volatile LAS unsigned* st) {
    XcdBarrier b; b.bar = bar; b.x = xb_xcc_id(); b.st = st;
    if (threadIdx.x == 0) (void)xb_add(&bar[XB_XCNT(b.x)], 1u);
    return b;
}
__device__ __forceinline__ void xcd_barrier_complete(unsigned* bar, unsigned x, unsigned& nloc, unsigned& nx) {
    const unsigned G = gridDim.x * gridDim.y * gridDim.z;
    unsigned sum, cnt, mine, sp = 0u;
    for (;;) {
        sum = 0u; cnt = 0u; mine = 0u;
#pragma unroll
        for (unsigned j = 0; j < 16; ++j) { const unsigned c = xb_ld(&bar[XB_XCNT(j)]); sum += c; cnt += (c > 0u) ? 1u : 0u; mine = (j == x) ? c : mine; }
        if (sum == G) break;
        __builtin_amdgcn_s_sleep(1);
        if ((++sp & 255u) == 0u) { if (xb_ld(&bar[XB_TMO])) break; if (sp > XB_SPIN_CAP) { atomicAdd(&bar[XB_TMO], 1u); break; } }
    }
    nloc = mine > 0u ? mine : 1u; nx = cnt > 0u ? cnt : 1u;
}
__device__ __forceinline__ void xcd_barrier(const XcdBarrier& b) {
    asm volatile("s_waitcnt vmcnt(0)" ::: "memory");
    __syncthreads();
    if (threadIdx.x == 0) {
        unsigned* bar = b.bar;
        __builtin_amdgcn_s_waitcnt(0);
        unsigned nloc = b.st[0], nx = b.st[1];
        if (nloc == 0u) { xcd_barrier_complete(bar, b.x, nloc, nx); b.st[0] = nloc; b.st[1] = nx; }
        const unsigned old = xb_add(&bar[XB_XSUB(b.x)], 1u);
        const unsigned gen = old / nloc;
        if (old + 1u == (gen + 1u) * nloc) {
            __builtin_amdgcn_fence(__ATOMIC_RELEASE, "agent");
            asm volatile("s_waitcnt vmcnt(0)" ::: "memory");
            const unsigned og = xb_add(&bar[XB_TOP], 1u);
            const unsigned tg = og / nx;
            if (og + 1u == (tg + 1u) * nx) xb_add(&bar[XB_TOPGEN], 1u);
            else XB_SPIN(xb_ld(&bar[XB_TOPGEN]) == tg, bar);
            __builtin_amdgcn_fence(__ATOMIC_ACQUIRE, "agent");
            xb_add(&bar[XB_XGEN(b.x)], 1u);
            asm volatile("s_waitcnt vmcnt(0)" ::: "memory");
        } else {
            XB_SPIN(xb_ld(&bar[XB_XGEN(b.x)]) == gen, bar);
            __builtin_amdgcn_fence(__ATOMIC_ACQUIRE, "agent");
            asm volatile("s_waitcnt vmcnt(0)" ::: "memory");
        }
    }
    __syncthreads();
}

struct Args {
    const float *x, *c, *ctx, *c_ctx, *ada_w, *ada_b, *norm_g, *ffn1_w13, *ffn1_w2, *w_in, *b_merge, *rnn_conv_w, *rnn_conv_b, *lru_w_a, *lru_b_a, *lru_w_x, *lru_b_x,
        *lru_lambda, *sc_conv_w, *attn_sink, *w_branch, *w_out, *ffn2_w13, *ffn2_w2, *final_norm_g;
    float* out; unsigned char* ws; int ph_lo, ph_hi;
};
static_assert(sizeof(Args) == 27 * 8 + 8, "Args has no padding");

__device__ __forceinline__ void transpose_item(const float* W, int K, int N, bf16_t* WT, int k0, int n0, int drow0, LAS float* scr, int lane) {
    f32x4 v[8];
#pragma unroll
    for (int j = 0; j < 8; ++j) v[j] = *(const f32x4*)(W + (size_t)(k0 + (lane >> 3) + 8 * j) * N + n0 + 4 * (lane & 7));
#pragma unroll
    for (int j = 0; j < 8; ++j) { LAS float* d = scr + ((lane >> 3) + 8 * j) * 33 + 4 * (lane & 7); d[0] = v[j].x; d[1] = v[j].y; d[2] = v[j].z; d[3] = v[j].w; }
    LDS_WAIT(); asm volatile("" ::: "memory");
    const int c = lane & 7;
#pragma unroll
    for (int j = 0; j < 4; ++j) { const int n = (lane >> 3) + 8 * j; const LAS float* s = scr + (8 * c) * 33 + n;
        u32x4 o; o.x = pk2(s[0 * 33], s[1 * 33]); o.y = pk2(s[2 * 33], s[3 * 33]); o.z = pk2(s[4 * 33], s[5 * 33]); o.w = pk2(s[6 * 33], s[7 * 33]);
        *(GAS u32x4*)(WT + (size_t)(drow0 + n) * K + k0 + 8 * c) = o; }
    LDS_WAIT(); asm volatile("" ::: "memory");
}
__device__ __forceinline__ void transpose_matrix(const float* W, int K, int N, bf16_t* WT, int rowmode, LAS float* scr, int gw, int ngw, int lane) {
    const int nblk = N / 32, nitems = (K / 64) * nblk;
    for (int it = gw; it < nitems; it += ngw) {
        const int kb = it / nblk, nb = it - kb * nblk, n0 = 32 * nb;
        int drow0 = n0;
        if (rowmode == 1) { const int up = n0 >= DFF, j0 = up ? n0 - DFF : n0; drow0 = 256 * (j0 >> 7) + 128 * up + (j0 & 127); }
        if (rowmode == 2 && n0 >= 5120 && n0 < 6400) {
            const int tb = 5120 + (((n0 - 5120) >> 8) << 8), hh = ((n0 - tb) >> 7) & 1, d0 = (n0 - tb) & 127; drow0 = tb + ((d0 & 32) ? 128 : 0) + hh * 64 + ((d0 >> 6) << 5); }
        if (rowmode == 2 && n0 >= 3072 && n0 < 5120) { const int wh = n0 >= 4096, j0 = n0 - 3072 - wh * 1024; drow0 = 3072 + 256 * (j0 >> 7) + 128 * wh + (j0 & 127); }
        transpose_item(W, K, N, WT, 64 * kb, n0, drow0, scr, lane);
    }
}
__device__ __forceinline__ void convert_weights(const Args& a, int layer, LAS unsigned char* lds, int gw, int ngw, int wave, int lane) {
    LAS float* scr = (LAS float*)(lds + wave * 16384);
    unsigned char* wb = a.ws + WS_W + (size_t)layer * W_REGION;
    transpose_matrix(a.ffn1_w13 + (size_t)layer * DM * 2 * DFF, DM, 2 * DFF, (bf16_t*)(wb + W_13), 1, scr, gw, ngw, lane);
    transpose_matrix(a.ffn1_w2 + (size_t)layer * DFF * DM, DFF, DM, (bf16_t*)(wb + W_2), 0, scr, gw, ngw, lane);
    transpose_matrix(a.w_in + (size_t)layer * DM * INC, DM, INC, (bf16_t*)(wb + W_IN), 2, scr, gw, ngw, lane);
    for (int i = 0; i < 3; ++i)
        transpose_matrix(a.w_branch + ((size_t)layer * 3 + i) * 1024 * DM, 1024, DM, (bf16_t*)(wb + W_BR) + (size_t)i * DM * 1024, 0, scr, gw, ngw, lane);
    transpose_matrix(a.w_out + (size_t)layer * DM * DM, DM, DM, (bf16_t*)(wb + W_OUT), 0, scr, gw, ngw, lane);
    transpose_matrix(a.ffn2_w13 + (size_t)layer * DM * 2 * DFF, DM, 2 * DFF, (bf16_t*)(wb + W_13B), 1, scr, gw, ngw, lane);
    transpose_matrix(a.ffn2_w2 + (size_t)layer * DFF * DM, DFF, DM, (bf16_t*)(wb + W_2B), 0, scr, gw, ngw, lane);
    bf16_t* wg = (bf16_t*)(wb + W_GAT);
    for (int it = gw * 64 + lane; it < 4096 * 16; it += ngw * 64) {
        const int row = it >> 4, din0 = (it & 15) * 8;
        const int tile = row >> 8, gate = (row >> 7) & 1, e = row & 127, d = tile >> 3, q = tile & 7;
        const float* src = (gate ? a.lru_w_x : a.lru_w_a) + ((((size_t)layer * 2 + d) * 8 + q) * 128 + din0) * 128 + e;
        u32x4 o; o.x = pk2(src[0 * 128], src[1 * 128]); o.y = pk2(src[2 * 128], src[3 * 128]); o.z = pk2(src[4 * 128], src[5 * 128]); o.w = pk2(src[6 * 128], src[7 * 128]);
        *(u32x4*)(wg + (size_t)row * 128 + din0) = o;
    }
}
__device__ __forceinline__ void ada_mods(const Args& a, LAS unsigned char* lds, int tid, int wave, int lane) {
    LAS float* sv = (LAS float*)lds;
    for (int i = tid; i < 5 * DM; i += 512) { const int v = i / DM, k = i - v * DM; const float cv = (v < 4) ? a.c[v * DM + k] : a.c_ctx[k]; sv[i] = cv / (1.0f + __expf(-cv)); }
    __syncthreads();
    float* MOD = (float*)(a.ws + WS_MOD);
    LAS f32x4* red4 = (LAS f32x4*)(lds + 40960);
    for (int vb = blockIdx.x; vb < 256; vb += gridDim.x) {
        const int l = vb >> 7, c0 = (vb & 127) * 144;
        const int cg = tid % 36, ks = tid / 36;
        if (ks < 14) {
            const float* W = a.ada_w + (size_t)l * DM * (NMOD * DM) + c0 + cg * 4;
            f32x4 acc[5];
#pragma unroll
            for (int v = 0; v < 5; ++v) acc[v] = (f32x4){0.f, 0.f, 0.f, 0.f};
#pragma unroll 8
            for (int k = ks; k < DM; k += 14) { const f32x4 w = *(const f32x4*)(W + (size_t)k * (NMOD * DM));
#pragma unroll
                for (int v = 0; v < 5; ++v) acc[v] += w * sv[v * DM + k]; }
#pragma unroll
            for (int v = 0; v < 5; ++v) red4[(ks * 36 + cg) * 5 + v] = acc[v];
        }
        __syncthreads();
        for (int o = tid; o < 5 * 144; o += 512) { const int v = o / 144, c = o - v * 144; float sum = 0.f;
#pragma unroll
            for (int q = 0; q < 14; ++q) sum += ((LAS float*)(red4 + (q * 36 + (c >> 2)) * 5 + v))[c & 3];
            MOD[((size_t)l * 5 + v) * (NMOD * DM) + c0 + c] = sum + a.ada_b[l * (NMOD * DM) + c0 + c]; }
        __syncthreads();
    }
}

__device__ __forceinline__ void prescale_phase(const float* srcC, const float* srcL, const float* g, const float* modl, int iscale, bf16_t* U, unsigned long long* ssq, int gw, int ngw, int lane) {
    f32x4 cf[8]; int cv = -1;
    for (int m = gw; m < MT; m += ngw) {
        const bool isc = m < MC; const int v = isc ? 4 : ((m - MC) >> 13);
        if (v != cv) { cv = v; const f32x4* sc = (const f32x4*)(modl + (size_t)v * (NMOD * DM) + iscale * DM) + lane; const f32x4* gp = (const f32x4*)g + lane;
#pragma unroll
            for (int j = 0; j < 8; ++j) cf[j] = gp[64 * j] * (sc[64 * j] + 1.0f); }
        const f32x4* xr = (const f32x4*)(isc ? srcC + (size_t)m * DM : srcL + (size_t)(m - MC) * DM) + lane;
        f32x4 x[8]; float ss = 0.f;
#pragma unroll
        for (int j = 0; j < 8; ++j) { x[j] = __builtin_nontemporal_load(xr + 64 * j); ss += (x[j].x * x[j].x + x[j].y * x[j].y) + (x[j].z * x[j].z + x[j].w * x[j].w); }
        ss = wave_sum(ss);
        if (lane == 0) ssq[m] = (unsigned long long)(ss * pg8::SSQ_SCALE);
        u32x2* o = (u32x2*)(U + (size_t)m * DM) + lane;
#pragma unroll
        for (int j = 0; j < 8; ++j) { const f32x4 y = x[j] * cf[j];
            u32x2 w; w.x = pk2(y.x, y.y); w.y = pk2(y.z, y.w); o[64 * j] = w; }
    }
}
__device__ __forceinline__ void shiftw_phase(const Args& a, int layer, LAS unsigned char* lds, int tid, int gw, int ngw, int lane) {
    LAS float* sh = (LAS float*)lds;
    const float* modl = (const float*)(a.ws + WS_MOD) + (size_t)layer * 5 * (NMOD * DM);
    float* SW = (float*)(a.ws + WS_SW) + (size_t)layer * 3 * 5 * SWLD;
#pragma unroll 1
    for (int kind = 0; kind < 3; ++kind) {
        const int N = kind == 1 ? INC : 2 * DFF, ish = 3 * kind;
        const bf16_t* Wt = (const bf16_t*)(a.ws + WS_W + (size_t)layer * W_REGION + (kind == 0 ? W_13 : (kind == 1 ? W_IN : W_13B)));
        __syncthreads();
        for (int i = tid; i < 5 * DM; i += 512) { const int v = i >> 11, k = i & (DM - 1); sh[i] = modl[(size_t)v * (NMOD * DM) + ish * DM + k]; }
        __syncthreads();
        for (int n = gw; n < N; n += ngw) {
            const bf16_t* wr_ = Wt + (size_t)n * DM + lane * 8;
            float w[4][8];
#pragma unroll
            for (int j = 0; j < 4; ++j) unpack8(*(const u32x4*)(wr_ + 512 * j), w[j]);
            float accv[5];
#pragma unroll
            for (int v = 0; v < 5; ++v) { float s_ = 0.f;
#pragma unroll
                for (int j = 0; j < 4; ++j) { const LAS f32x4* sp = (const LAS f32x4*)(sh + v * DM + lane * 8 + 512 * j); const f32x4 s0 = sp[0], s1 = sp[1];
                    s_ += (w[j][0] * s0[0] + w[j][1] * s0[1]) + (w[j][2] * s0[2] + w[j][3] * s0[3]) + (w[j][4] * s1[0] + w[j][5] * s1[1]) + (w[j][6] * s1[2] + w[j][7] * s1[3]); }
                accv[v] = wave_sum(s_); }
            if (lane < 5) { float r = accv[0]; r = lane == 1 ? accv[1] : r; r = lane == 2 ? accv[2] : r; r = lane == 3 ? accv[3] : r; r = lane == 4 ? accv[4] : r;
                SW[((size_t)kind * 5 + lane) * SWLD + n] = r; }
        }
    }
    __syncthreads();
}

__device__ __forceinline__ void prep_phase(const Args& a, int layer, int gtid, int ngt, int tid, int bx, int G) {
    unsigned char* zb = a.ws + WS_Z; unsigned char* cb = a.ws + WS_CR;
    const bf16_t* ZT = (const bf16_t*)zb;
    bf16_t* XA = (bf16_t*)(cb + C_XA); bf16_t* YS = (bf16_t*)(cb + C_YS); bf16_t* QR = (bf16_t*)(cb + C_QR); bf16_t* KR = (bf16_t*)(cb + C_KR); bf16_t* VT = (bf16_t*)(cb + C_VT);
    const float* cw = a.rnn_conv_w + (size_t)layer * 4 * 1024; const float* cbias = a.rnn_conv_b + (size_t)layer * 1024; const float* sw = a.sc_conv_w + (size_t)layer * 3 * 1024;
#define SEQID(m_) ((m_) < MC ? ((m_) >> 8) : 4 + (((m_) - MC) >> 13))
    for (int it = gtid; it < (MT / 64) * 3 * 128; it += ngt) {
        const int c0 = (it & 127) * 8, q3 = it >> 7, blk = q3 / 3, t3 = q3 - 3 * blk;
        const int m = blk * 64 + (t3 == 0 ? 0 : (t3 == 1 ? 1 : 63));
        const int sid = SEQID(m);
        const float v2 = (m >= 2 && SEQID(m - 2) == sid) ? 1.f : 0.f, v1 = (m >= 1 && SEQID(m - 1) == sid) ? 1.f : 0.f, vp = (m + 1 < MT && SEQID(m + 1) == sid) ? 1.f : 0.f;
        const int r2 = m >= 2 ? m - 2 : 0, r1 = m >= 1 ? m - 1 : 0, rp = m + 1 < MT ? m + 1 : MT - 1;
        float xm2[8], xm1[8], x0[8], xp1[8], o[8];
        unpack8(*(const u32x4*)(ZT + zt(r2, c0)), xm2); unpack8(*(const u32x4*)(ZT + zt(r1, c0)), xm1); unpack8(*(const u32x4*)(ZT + zt(m, c0)), x0); unpack8(*(const u32x4*)(ZT + zt(rp, c0)), xp1);
#pragma unroll
        for (int e = 0; e < 8; ++e) o[e] = cbias[c0 + e] + (cw[c0 + e] * xm2[e]) * v2 + (cw[1024 + c0 + e] * xm1[e]) * v1 + cw[2048 + c0 + e] * x0[e] + (cw[3072 + c0 + e] * xp1[e]) * vp;
        *(u32x4*)(XA + (size_t)m * 1024 + c0) = pack8(o);
    }
    {
        const int c0 = (tid & 127) * 8, strip = tid >> 7;
        const int rpw = (MT + G - 1) / G, rps = (rpw + 3) / 4;
        const int mb = bx * rpw + strip * rps;
        int me = mb + rps; me = me < bx * rpw + rpw ? me : bx * rpw + rpw; me = me < MT ? me : MT;
        float swv[3][8];
#pragma unroll
        for (int e = 0; e < 8; ++e) {
#pragma unroll
            for (int j = 0; j < 3; ++j) swv[j][e] = sw[j * 1024 + c0 + e]; }
#define LDROW(dst, p_, col_) do { const int pc_ = (p_) < 0 ? 0 : ((p_) >= MT ? MT - 1 : (p_)); unpack8(*(const u32x4*)(ZT + zt(pc_, (col_) + c0)), dst); } while (0)
        float pm1[8], p0[8];
        if (mb < me) { LDROW(pm1, mb - 1, 3072); LDROW(p0, mb, 3072); }
#define LDRAW(dst, p_, col_) do { const int pc_ = (p_) < 0 ? 0 : ((p_) >= MT ? MT - 1 : (p_)); dst = *(const u32x4*)(ZT + zt(pc_, (col_) + c0)); } while (0)
        u32x4 qp[2], qb[2];
#pragma unroll
        for (int i = 0; i < 2; ++i) { LDRAW(qp[i], mb + 1 + i, 3072); LDRAW(qb[i], mb + i, 2048); }
#pragma unroll 1
        for (int m = mb; m < me; ++m) {
            float pp1[8], bv[8];
            unpack8(qp[0], pp1); unpack8(qb[0], bv);
            qp[0] = qp[1]; qb[0] = qb[1];
            LDRAW(qp[1], m + 3, 3072); LDRAW(qb[1], m + 2, 2048);
            const int sid = SEQID(m);
            const float v1 = (m >= 1 && SEQID(m - 1) == sid) ? 1.f : 0.f, vp = (m + 1 < MT && SEQID(m + 1) == sid) ? 1.f : 0.f;
            float accy[8];
#pragma unroll
            for (int e = 0; e < 8; ++e) accy[e] = bv[e] * ((swv[0][e] * pm1[e]) * v1 + swv[1][e] * p0[e] + (swv[2][e] * pp1[e]) * vp);
            *(u32x4*)(YS + (size_t)m * 3072 + 1024 + c0) = pack8(accy);
#pragma unroll
            for (int e = 0; e < 8; ++e) { pm1[e] = p0[e]; p0[e] = pp1[e]; }
        }
#undef SEQID
#undef LDROW
#undef LDRAW
    }
    for (int it = gtid; it < NB * 2 * 16 * SEQV; it += ngt) {
        const int s = it % SEQV, r = it / SEQV, dg = r & 15, kvh = (r >> 4) & 1, b = r >> 5;
        const int m = s < CTXL ? b * CTXL + s : MC + b * SEQ + (s - CTXL);
        const u32x4 w = *(const u32x4*)(ZT + zt(m, 6400 + kvh * 128 + dg * 8));
        bf16_t* dp = VT + ((size_t)(b * 2 + kvh) * 128 + dg * 8) * SEQV + s;
        dp[0 * SEQV] = (bf16_t)(w.x & 0xffffu); dp[1 * SEQV] = (bf16_t)(w.x >> 16); dp[2 * SEQV] = (bf16_t)(w.y & 0xffffu); dp[3 * SEQV] = (bf16_t)(w.y >> 16);
        dp[4 * SEQV] = (bf16_t)(w.z & 0xffffu); dp[5 * SEQV] = (bf16_t)(w.z >> 16); dp[6 * SEQV] = (bf16_t)(w.w & 0xffffu); dp[7 * SEQV] = (bf16_t)(w.w >> 16);
    }
}

constexpr int AT_KROW = 272, AT_VROW = 72, AT_KB = 32 * AT_KROW, AT_VB = 128 * AT_VROW, AT_TILE = AT_KB + AT_VB;
__device__ __forceinline__ void attn_tile(f32x16 (&O)[4], float& m_run, float& l_run, const bf16x8 (&qf)[8], const LAS unsigned char* kp, const LAS unsigned char* vp, int mode, int dq, float sc2, int half) {
    f32x16 s;
#pragma unroll
    for (int i = 0; i < 16; ++i) s[i] = 0.f;
    bf16x8 kf[8];
#pragma unroll
    for (int ks = 0; ks < 8; ++ks) kf[ks] = *(const LAS bf16x8*)(kp + 32 * ks);
    s16x4 vlo[2][4], vhi[2][4];
#pragma unroll
    for (int s2 = 0; s2 < 2; ++s2)
#pragma unroll
        for (int dt = 0; dt < 4; ++dt) { const LAS unsigned char* vq = vp + (32 * dt) * AT_VROW + 32 * s2; vlo[s2][dt] = *(const LAS s16x4*)vq; vhi[s2][dt] = *(const LAS s16x4*)(vq + 16); }
#pragma unroll
    for (int ks = 0; ks < 8; ++ks) s = __builtin_amdgcn_mfma_f32_32x32x16_bf16(kf[ks], qf[ks], s, 0, 0, 0);
    float tmax = -3.0e38f;
#pragma unroll
    for (int r = 0; r < 16; ++r) tmax = fmaxf(tmax, s[r]);
    if (mode != 0) {
        const int klo = mode == 1 ? dq - 128 : -100000, khi = mode == 2 ? dq + 128 : 100000;
        tmax = -3.0e38f;
#pragma unroll
        for (int r = 0; r < 16; ++r) { const int key = (r & 3) + 8 * (r >> 2) + 4 * half; float t = s[r];
            if (key < klo || key > khi) t = -1.0e30f;
            s[r] = t; tmax = fmaxf(tmax, t); }
    }
    tmax = fmaxf(tmax, __shfl_xor(tmax, 32));
    const float tms = tmax * sc2, m_new = (tms - m_run > 8.0f) ? tms : m_run;
    if (__builtin_amdgcn_ballot_w64(m_new != m_run) != 0) {
        const float alpha = __builtin_amdgcn_exp2f(m_run - m_new);
        m_run = m_new; l_run *= alpha;
#pragma unroll
        for (int dt = 0; dt < 4; ++dt)
#pragma unroll
            for (int r = 0; r < 16; ++r) O[dt][r] *= alpha;
    }
    float ls = 0.f;
#pragma unroll
    for (int r = 0; r < 16; ++r) { const float p = __builtin_amdgcn_exp2f(__builtin_fmaf(s[r], sc2, -m_run)); s[r] = p; ls += p; }
    l_run += ls;
#pragma unroll
    for (int s2 = 0; s2 < 2; ++s2) {
        u32x4 pw; pw.x = pk2(s[8 * s2 + 0], s[8 * s2 + 1]); pw.y = pk2(s[8 * s2 + 2], s[8 * s2 + 3]); pw.z = pk2(s[8 * s2 + 4], s[8 * s2 + 5]); pw.w = pk2(s[8 * s2 + 6], s[8 * s2 + 7]);
        const bf16x8 pf = __builtin_bit_cast(bf16x8, pw);
#pragma unroll
        for (int dt = 0; dt < 4; ++dt) {
            const bf16x8 vf = __builtin_shufflevector(vlo[s2][dt], vhi[s2][dt], 0, 1, 2, 3, 4, 5, 6, 7);
            O[dt] = __builtin_amdgcn_mfma_f32_32x32x16_bf16(vf, pf, O[dt], 0, 0, 0);
        }
    }
}
__device__ __forceinline__ void attn_phase(const Args& a, int layer, LAS unsigned char* lds, int tid, int wave, int lane) {
    unsigned char* cb = a.ws + WS_CR;
    const bf16_t* QR = (const bf16_t*)(cb + C_QR); const bf16_t* KR = (const bf16_t*)(cb + C_KR); const bf16_t* VT = (const bf16_t*)(cb + C_VT); bf16_t* YS = (bf16_t*)(cb + C_YS);
    const int half = lane >> 5, r31 = lane & 31;
    const float sc2 = 0.08838834764831845f * LOG2E;
    const int nunits = layer == 1 ? 1024 : 1024 + 32;
    const int krow_s = tid >> 4, kc_s = tid & 15, vrow_s = tid >> 2, vc_s = tid & 3;
    const int G_ = gridDim.x, nr = (1024 + G_ - 1) / G_;
    for (int it = 0; ; ++it) {
        int u;
        if (it < nr) { u = blockIdx.x + it * G_; if (u >= 1024) continue; }
        else { u = 1024 + (G_ - 1 - (int)blockIdx.x) + (it - nr) * G_; if (u >= nunits) break; }
        int b, kvh, qb; bool isc;
        if (u < 1024) { isc = false; b = u >> 8; kvh = (u >> 7) & 1; qb = u & 127; } else { const int uc = u - 1024; isc = true; b = uc >> 3; kvh = (uc >> 2) & 1; qb = uc & 3; }
        const int th = wave & 1, g = wave >> 1, hq = kvh * 4 + g, t0 = qb * 64, tq0 = t0 + th * 32;
        const int qrow0 = isc ? b * CTXL : MC + b * SEQ;
        const int klo = isc ? 0 : (t0 >= 128 ? -4 : -(t0 >> 5)), khi = isc ? -1 : ((SEQ - t0) / 32 - 1 < 5 ? (SEQ - t0) / 32 - 1 : 5);
        const int nloc = khi - klo + 1, nt = nloc + 8;
        bf16x8 qf[8];
        { const bf16_t* qp = QR + (size_t)(qrow0 + tq0 + r31) * 1024 + hq * 128 + 8 * half;
#pragma unroll
          for (int ks = 0; ks < 8; ++ks) qf[ks] = *(const bf16x8*)(qp + 16 * ks);
#pragma unroll
          for (int ks = 0; ks < 8; ++ks) asm volatile("" :: "v"(qf[ks])); }
        f32x16 O[4];
#pragma unroll
        for (int dt = 0; dt < 4; ++dt)
#pragma unroll
            for (int r = 0; r < 16; ++r) O[dt][r] = 0.f;
        float m_run = a.attn_sink[layer * 8 + hq] * LOG2E, l_run = half == 0 ? 1.0f : 0.0f;
        const bf16_t* kg0 = KR + (size_t)krow_s * 256 + kvh * 128 + kc_s * 8;
        const bf16_t* vg0 = VT + ((size_t)(b * 2 + kvh) * 128 + vrow_s) * SEQV + vc_s * 8;
#define AT_LOAD(kr_, vr_, i_) do { const int i1_ = (i_), loc_ = i1_ < nloc; const int krow0_ = loc_ ? MC + b * SEQ + t0 + 32 * (klo + i1_) : b * CTXL + 32 * (i1_ - nloc), vcol0_ = loc_ ? CTXL + t0 + 32 * (klo + i1_) : 32 * (i1_ - nloc); \
            kr_ = *(const u32x4*)(kg0 + (size_t)krow0_ * 256); vr_ = *(const u32x4*)(vg0 + vcol0_); } while (0)
#define AT_STORE(kr_, vr_, buf_) do { LAS unsigned char* bp_ = lds + (buf_) * AT_TILE; *(LAS u32x4*)(bp_ + krow_s * AT_KROW + kc_s * 16) = kr_; \
            *(LAS u32x2*)(bp_ + AT_KB + vrow_s * AT_VROW + vc_s * 16) = (u32x2){vr_.x, vr_.y}; *(LAS u32x2*)(bp_ + AT_KB + vrow_s * AT_VROW + vc_s * 16 + 8) = (u32x2){vr_.z, vr_.w}; } while (0)
        u32x4 kregA, vregA, kregB, vregB;
        AT_LOAD(kregA, vregA, 0); AT_STORE(kregA, vregA, 0);
        AT_LOAD(kregA, vregA, 1);
        __syncthreads();
#define AT_STEP(i_, krN_, vrN_, krS_, vrS_) do { const int ii_ = (i_); \
            AT_LOAD(krN_, vrN_, ii_ + 2 < nt ? ii_ + 2 : nt - 1);    \
            const LAS unsigned char* bufp = lds + (ii_ & 1) * AT_TILE; \
            const LAS unsigned char* kp = bufp + r31 * AT_KROW + 16 * half; const LAS unsigned char* vp = bufp + AT_KB + r31 * AT_VROW + 8 * half; \
            { const int kt = klo + ii_, rel = kt - th;             \
              const bool loc = ii_ < nloc, need = !loc || (rel >= -4 && rel <= 4); \
              const int mode = loc ? (rel == -4 ? 1 : (rel == 4 ? 2 : 0)) : 0, dq = loc ? tq0 + r31 - (t0 + 32 * kt) : 0; \
              if (need) attn_tile(O, m_run, l_run, qf, kp, vp, mode, dq, sc2, half); } \
            if (ii_ + 1 < nt) AT_STORE(krS_, vrS_, (ii_ + 1) & 1);    \
            __syncthreads(); } while (0)
#pragma unroll 1
        for (int i = 0; i < nt; i += 2) {
            AT_STEP(i, kregB, vregB, kregA, vregA);
            if (i + 1 < nt) AT_STEP(i + 1, kregA, vregA, kregB, vregB);
        }
#undef AT_STEP
#undef AT_LOAD
#undef AT_STORE
        const float lt = l_run + __shfl_xor(l_run, 32), inv = 1.0f / lt;
        bf16_t* op = YS + (size_t)(qrow0 + tq0 + r31) * 3072 + 2048 + hq * 128 + 4 * half;
#pragma unroll
        for (int dt = 0; dt < 4; ++dt)
#pragma unroll
            for (int rg = 0; rg < 4; ++rg) { u32x2 w; w.x = pk2(O[dt][4 * rg] * inv, O[dt][4 * rg + 1] * inv); w.y = pk2(O[dt][4 * rg + 2] * inv, O[dt][4 * rg + 3] * inv);
                *(u32x2*)(op + 32 * dt + 8 * rg) = w; }
    }
}

__device__ __forceinline__ int chain_chunk(int d, int b, int p) {
    if (d == 0) return p < 2 ? 2 * b + p : 8 + 64 * b + (p - 2);
    return p < 2 ? 2 * b + 1 - p : 8 + 64 * b + 63 - (p - 2);
}
__device__ __forceinline__ void lane_scan8(const u32x4 p0, const u32x4 p1, int d, float (&hl)[8], float (&pl)[8]) {
    const float lv[8] = {bflo(p0.x), bflo(p0.y), bflo(p0.z), bflo(p0.w), bflo(p1.x), bflo(p1.y), bflo(p1.z), bflo(p1.w)};
    const float uv[8] = {bfhi(p0.x), bfhi(p0.y), bfhi(p0.z), bfhi(p0.w), bfhi(p1.x), bfhi(p1.y), bfhi(p1.z), bfhi(p1.w)};
    float H = 0.f, P = 1.f;
    if (d == 0) {
#pragma unroll
        for (int k = 0; k < 8; ++k) { const float av = __builtin_amdgcn_exp2f(lv[k]); H = av * H + uv[k]; P *= av; hl[k] = H; pl[k] = P; }
    } else {
#pragma unroll
        for (int k = 7; k >= 0; --k) { const float av = __builtin_amdgcn_exp2f(lv[k]); H = av * H + uv[k]; P *= av; hl[k] = H; pl[k] = P; }
    }
}
__device__ __forceinline__ void scan_summaries(const Args& a, int gw, int ngw, int lane) {
    const unsigned* LU = (const unsigned*)(a.ws + WS_Z + Z_LA);
    f32x2* SM = (f32x2*)(a.ws + WS_SUMM);
    const int j = lane & 15, g = lane >> 4;
    for (int it = gw; it < 2 * 256 * 66; it += ngw) {
        const int q = it % 66, r = it / 66, c4 = (r & 255) * 4, d = r >> 8;
        const int chunk = 4 * q + g;
        const size_t base = ((size_t)d * 1024 + c4) * MT + (size_t)chunk * 128 + 8 * j;
        u32x4 lw[4], uw[4];
#pragma unroll
        for (int e = 0; e < 4; ++e) { lw[e] = *(const u32x4*)(LU + base + (size_t)e * MT); uw[e] = *(const u32x4*)(LU + base + (size_t)e * MT + 4); }
#pragma unroll
        for (int e = 0; e < 4; ++e) {
            float hl[8], pl[8]; lane_scan8(lw[e], uw[e], d, hl, pl);
            float P = d == 0 ? pl[7] : pl[0], H = d == 0 ? hl[7] : hl[0];
#pragma unroll
            for (int sft = 1; sft < 16; sft <<= 1) {
                const float Pq = __shfl_xor(P, sft, 16), Hq = __shfl_xor(H, sft, 16);
                const bool mine_first = (d == 0) ? ((j & sft) == 0) : ((j & sft) != 0);
                const float Px = mine_first ? P : Pq, Hx = mine_first ? H : Hq, Py = mine_first ? Pq : P, Hy = mine_first ? Hq : H;
                P = Px * Py; H = Py * Hx + Hy;
            }
            if (j == 0) SM[((size_t)d * NCHUNK + chunk) * 1024 + c4 + e] = (f32x2){P, H};
        }
    }
}
__device__ __forceinline__ int chain_half(int d, int b, int p) {
    if (d == 0) return p < 4 ? 4 * b + p : 16 + 128 * b + (p - 4);
    return p < 4 ? 4 * b + 3 - p : 16 + 128 * b + 127 - (p - 4);
}
__device__ __forceinline__ void scan_carries(const Args& a, int bx, int wave, int lane) {
    if (wave != 0 || bx >= 128) return;
    const f32x2* SM = (const f32x2*)(a.ws + WS_SUMM); float* CY = (float*)(a.ws + WS_CARRY);
    const int d = bx >> 6, b = (bx >> 4) & 3, ch = (bx & 15) * 64 + lane;
    float h = 0.f;
#pragma unroll 1
    for (int p0 = 0; p0 < 132; p0 += 22) {
        f32x2 sm[22];
#pragma unroll
        for (int i = 0; i < 22; ++i) sm[i] = SM[((size_t)d * 528 + chain_half(d, b, p0 + i)) * 1024 + ch];
#pragma unroll
        for (int i = 0; i < 22; ++i) { const int hc = chain_half(d, b, p0 + i);
            if ((hc & 1) == d) CY[((size_t)d * NCHUNK + (hc >> 1)) * 1024 + ch] = h;
            h = sm[i].x * h + sm[i].y; }
    }
}
__device__ __forceinline__ float gelu_tanh(float x) { const float y = 0.7978845608028654f * (x + 0.044715f * x * x * x); const float e = __expf(2.0f * y); const float th = 1.0f - 2.0f * __builtin_amdgcn_rcpf(e + 1.0f); return 0.5f * x * (1.0f + th); }
__device__ __forceinline__ void scan_final(const Args& a, int gw, int ngw, int lane, int layer) {
    const unsigned* LU = (const unsigned*)(a.ws + WS_Z + Z_LA); const bf16_t* ZT = (const bf16_t*)(a.ws + WS_Z);
    const float* CY = (const float*)(a.ws + WS_CARRY); bf16_t* YS = (bf16_t*)(a.ws + WS_CR + C_YS);
    const int j = lane & 15, g = lane >> 4;
    const int chunk0 = layer == 1 ? 8 : 0;
    const int NT = (NCHUNK - chunk0) * 32, full = (NT / ngw) * ngw, RT = NT - full; const bool split = RT > 0 && 2 * RT <= ngw;
    const int nmine = full / ngw + ((split ? gw < 2 * RT : gw < RT) ? 1 : 0);
#pragma unroll 1
    for (int it = 0; it < nmine; ++it) {
        const bool tail = split && it * ngw >= full;
        const int wt = tail ? full + (gw >> 1) : it * ngw + gw, eh0 = tail ? (gw & 1) : 0, eh1 = tail ? eh0 + 1 : 2;
        const int chunk = S2REV ? NCHUNK - 1 - (wt >> 5) : chunk0 + (wt >> 5), c8 = (wt & 31) * 32 + g * 8;
        const int row0 = chunk * 128 + 8 * j;
        const float cv = CY[((size_t)(j >> 3) * NCHUNK + chunk) * 1024 + c8 + (j & 7)];
#pragma unroll 1
        for (int eh = eh0; eh < eh1; ++eh) {
            const int c4 = c8 + eh * 4;
            u32x4 lw[2][4], uw[2][4]; u32x2 rgw[8];
#pragma unroll
            for (int d = 0; d < 2; ++d)
#pragma unroll
                for (int e = 0; e < 4; ++e) { const size_t off = ((size_t)d * 1024 + c4 + e) * MT + row0; lw[d][e] = *(const u32x4*)(LU + off); uw[d][e] = *(const u32x4*)(LU + off + 4); }
#pragma unroll
            for (int k = 0; k < 8; ++k) rgw[k] = *(const u32x2*)(ZT + zt(row0 + k, 1024 + c4));
            float acc[8][4];
#pragma unroll
            for (int e = 0; e < 4; ++e) {
#pragma unroll
                for (int d = 0; d < 2; ++d) {
                    float hl[8], pl[8]; lane_scan8(lw[d][e], uw[d][e], d, hl, pl);
                    float Pi = d == 0 ? pl[7] : pl[0], Hi = d == 0 ? hl[7] : hl[0];
#pragma unroll
                    for (int sft = 1; sft < 16; sft <<= 1) {
                        const float Pp = d == 0 ? __shfl_up(Pi, sft, 16) : __shfl_down(Pi, sft, 16), Hp = d == 0 ? __shfl_up(Hi, sft, 16) : __shfl_down(Hi, sft, 16);
                        const bool has = d == 0 ? (j >= sft) : (j + sft <= 15);
                        if (has) { Hi = Pi * Hp + Hi; Pi = Pi * Pp; }
                    }
                    float Pe = d == 0 ? __shfl_up(Pi, 1, 16) : __shfl_down(Pi, 1, 16), He = d == 0 ? __shfl_up(Hi, 1, 16) : __shfl_down(Hi, 1, 16);
                    if (d == 0 ? (j == 0) : (j == 15)) { Pe = 1.f; He = 0.f; }
                    const float c0 = __shfl(cv, eh * 4 + e + 8 * d, 16);
                    const float sj = Pe * c0 + He;
#pragma unroll
                    for (int k = 0; k < 8; ++k) { const float hv = hl[k] + pl[k] * sj; if (d == 0) acc[k][e] = hv; else acc[k][e] += hv; }
                }
            }
#pragma unroll
            for (int k = 0; k < 8; ++k) { const float r0 = bflo(rgw[k].x), r1 = bfhi(rgw[k].x), r2 = bflo(rgw[k].y), r3 = bfhi(rgw[k].y);
                u32x2 w; w.x = pk2(acc[k][0] * gelu_tanh(r0), acc[k][1] * gelu_tanh(r1)); w.y = pk2(acc[k][2] * gelu_tanh(r2), acc[k][3] * gelu_tanh(r3));
                *(u32x2*)(YS + (size_t)(row0 + k) * 3072 + c4) = w; }
        }
    }
}

constexpr int NPH = 32;
__device__ __forceinline__ Args load_args() {
#if defined(__HIP_DEVICE_COMPILE__)
    typedef const __attribute__((address_space(4))) Args* KA;
    KA p = (KA)__builtin_amdgcn_kernarg_segment_ptr(); asm volatile("" : "+s"(p)); return *(const Args*)p;
#else
    return Args{};
#endif
}
#define PHASE_BEGIN() const Args a = load_args(); int tid = threadIdx.x; asm volatile("" : "+v"(tid)); const int lane = tid & 63, wave = __builtin_amdgcn_readfirstlane(tid >> 6); \
    const int G = gridDim.x, bx = blockIdx.x, gw = bx * NWAVES + wave, ngw = G * NWAVES, gtid = bx * 512 + tid, ngt = G * 512; \
    unsigned char* ws = a.ws; float* MOD = (float*)(ws + WS_MOD); float* C8 = (float*)(ws + WS_C8); unsigned long long* SSQ = (unsigned long long*)(ws + WS_SSQ); float* SW = (float*)(ws + WS_SW) + (size_t)layer * 3 * 5 * SWLD; bf16_t* U = (bf16_t*)(ws + WS_H); bf16_t* MG = (bf16_t*)a.out;     \
    unsigned char* wb = ws + WS_W + (size_t)layer * W_REGION; unsigned char* zb = ws + WS_Z; unsigned char* cb = ws + WS_CR; \
    const float* modl = MOD + (size_t)layer * 5 * (NMOD * DM); \
    (void)SSQ; (void)SW; (void)lane; (void)wave; (void)gw; (void)ngw; (void)gtid; (void)ngt; (void)C8; (void)U; (void)wb; (void)zb; (void)cb; (void)modl; (void)MG; (void)bx;

__global__ void __launch_bounds__(NWAVES * 64, 2) fwd_kernel(Args a_param) {
    extern __shared__ __attribute__((aligned(16))) unsigned char lds_raw[];
    LAS unsigned char* lds = (LAS unsigned char*)lds_raw;
    int lo, hi; XcdBarrier bar;
    {
        const Args a = load_args();
        volatile LAS unsigned* MISC = (volatile LAS unsigned*)(lds + MISC_OFF);
        unsigned* ctl = (unsigned*)(a.ws + WS_CTL);
        for (int u = threadIdx.x; u < (LDS_BYTES - LDSCTL_OFF) / 4; u += NWAVES * 64) ((LAS unsigned*)(lds + LDSCTL_OFF))[u] = 0u;
        __syncthreads();
        bar.bar = ctl + CW_BAR; bar.x = 0; bar.st = MISC + 8;
        if (MK_ONE_LAUNCH) bar = xcd_barrier_post(ctl + CW_BAR, MISC + 8);
        lo = a.ph_lo; hi = a.ph_hi;
    }
#ifndef ENMASK
#define ENMASK 0x1ffff
#endif
#define IN(k) (lo <= (k) && (k) < hi)
#define INP(p) (((ENMASK >> (p)) & 1) && IN(pb + (p)))
#define SEAM(k) do { xcd_barrier(bar); } while (0)
#ifndef DUPMASK
#define DUPMASK 0
#endif
#define REP(p) _Pragma("nounroll") for (int rep_ = 0; rep_ < 1 + ((DUPMASK >> (p)) & 1); ++rep_)

    if (((ENMASK >> 15) & 1) && IN(0)) {
        const int layer = 0; PHASE_BEGIN();
        REP(16) ada_mods(a, lds, tid, wave, lane);
        for (int i = gtid; i < 2 * 2 * 1024; i += ngt) { const float lam = a.lru_lambda[i]; C8[i] = -8.0f * log1pf(expf(-lam)); }
        for (int i = gtid; i < 128 * 32; i += ngt) { const float inv = powf(10000.0f, -(float)(i & 31) * (1.0f / 32.0f)); float sn, cs; sincosf((float)(i >> 5) * inv, &sn, &cs);
            ((float*)(ws + WS_ROPE))[i] = cs; ((float*)(ws + WS_ROPE))[4096 + i] = sn; }
        REP(17) convert_weights(a, 0, lds, gw, ngw, wave, lane);
        SEAM(0);
    }
#pragma nounroll
    for (int layer = 0; layer < 2; ++layer) {
        const int pb = 1 + 15 * layer;
        if (layer == 0 && INP(0)) { PHASE_BEGIN();
            shiftw_phase(a, 0, lds, tid, gw, ngw, lane);
            REP(0) prescale_phase(a.ctx, a.x, a.norm_g, modl, 1, U, SSQ, gw, ngw, lane);
            SEAM(pb + 0);
        }
        if (INP(1)) { PHASE_BEGIN();
            pg8::Gemm g{(const char*)U, (const char*)(wb + W_13), DM, DM, DM}; pg8::Order<4> S; S.ragged = false; S.lda2 = 0; S.so.init(MT, 2 * DFF, G, bx, WGM_G1, ((REVMASK >> 0) & 1) ^ (layer & REVLAYER)); S.pm0 = 0; S.lda2 = DM * 2;
            pg8::EpiSwiglu E{(bf16_t*)(zb + Z_ACT), SSQ + (size_t)(layer * 3 + 0) * MT, SW + (size_t)0 * 5 * SWLD};
            pg8::gemm_phase(lds, g, S, E, tid); if ((DUPMASK >> 1) & 1) { asm volatile("" : "+v"(tid)); pg8::gemm_phase(lds, g, S, E, tid); }
            asm volatile("" : "+v"(tid)); pg8::gemm_phase<pg8::EpiSwiglu, pg8::Order<4>, 2>(lds, g, S, E, tid);
            SEAM(pb + 1);
        }
        if (INP(2)) { PHASE_BEGIN();
            pg8::Gemm g{(const char*)(zb + Z_ACT), (const char*)(wb + W_2), DFF, DFF, DFF}; pg8::Order<3> S; S.ragged = (G == 256); S.lda2 = DFF * 2; S.so.init(S.ragged ? ML : MT, DM, G, bx, WGM_G2, ((REVMASK >> 1) & 1) ^ (layer & REVLAYER)); S.pm0 = 0;
            pg8::EpiResid E{U, modl + 2 * DM, a.norm_g + (size_t)(layer * 3 + 0) * DM, modl + 1 * DM, a.norm_g + (size_t)(layer * 3 + 1) * DM, modl + 4 * DM, SSQ + (size_t)(layer * 3 + 1) * MT, 0.5f};
            pg8::gemm_phase(lds, g, S, E, tid);
            { pg8::OrderQ SQ{bx, DFF * 2, S.ragged}; asm volatile("" : "+v"(tid)); pg8::gemm_phase<pg8::EpiResid, pg8::OrderQ, 1>(lds, g, SQ, E, tid); }
            SEAM(pb + 2);
        }
        if (INP(4)) { PHASE_BEGIN();
            pg8::Gemm g{(const char*)U, (const char*)(wb + W_IN), DM, DM, DM}; pg8::Order<4> S; S.ragged = false; S.lda2 = 0; S.so.init(MT, NZS, G, bx, WGM_G3, ((REVMASK >> 2) & 1) ^ (layer & REVLAYER)); S.pm0 = 0; S.lda2 = DM * 2;
            pg8::EpiStore E{(bf16_t*)zb, 256, (size_t)MT * 256, SSQ + (size_t)(layer * 3 + 1) * MT, SW + (size_t)1 * 5 * SWLD, (bf16_t*)(cb + C_QR), (bf16_t*)(cb + C_KR), (const float*)(ws + WS_ROPE), (bf16_t*)(cb + C_XA), a.rnn_conv_w + (size_t)layer * 4 * 1024, a.rnn_conv_b + (size_t)layer * 1024};
            pg8::gemm_phase(lds, g, S, E, tid); if ((DUPMASK >> 4) & 1) { asm volatile("" : "+v"(tid)); pg8::gemm_phase(lds, g, S, E, tid); }
            asm volatile("" : "+v"(tid)); pg8::gemm_phase<pg8::EpiStore, pg8::Order<4>, 2>(lds, g, S, E, tid);
            SEAM(pb + 4);
        }
        if (INP(5)) { PHASE_BEGIN(); REP(5) prep_phase(a, layer, gtid, ngt, tid, bx, G); SEAM(pb + 5); }
        if (INP(6)) { PHASE_BEGIN();
            const bool cvt1 = (layer == 0), cvfirst = ((bx >> 3) & 1) == 0;
            if (cvt1 && cvfirst) { convert_weights(a, 1, lds, gw, ngw, wave, lane); __syncthreads(); }
#ifndef NO_GA
            int gaK = 128; asm volatile("" : "+s"(gaK));     pg8::Gemm g{(const char*)(cb + C_XA), (const char*)(wb + W_GAT), 1024, 128, gaK}; pg8::Order<1> S; S.ragged = false; S.lda2 = 0; S.so.init(MT, 4096, G, bx, WGM_GA, ((REVMASK >> 3) & 1) ^ (layer & REVLAYER)); S.pm0 = 0;
            pg8::EpiGates E{(const bf16_t*)(cb + C_XA), (unsigned*)(zb + Z_LA), (f32x2*)(ws + WS_SUMM), a.lru_b_a + (size_t)layer * 2048, a.lru_b_x + (size_t)layer * 2048, C8 + (size_t)layer * 2048};
            pg8::gemm_phase(lds, g, S, E, tid); if ((DUPMASK >> 6) & 1) { asm volatile("" : "+v"(tid)); pg8::gemm_phase(lds, g, S, E, tid); }
#endif
#ifndef NO_ATT
            REP(15) attn_phase(a, layer, lds, tid, wave, lane);
#endif
            if (cvt1 && !cvfirst) { __syncthreads(); convert_weights(a, 1, lds, gw, ngw, wave, lane); }
            SEAM(pb + 6);
        }
        if (INP(7)) { PHASE_BEGIN(); scan_carries(a, bx, wave, lane); SEAM(pb + 7); }
        if (INP(8)) { PHASE_BEGIN(); REP(8) scan_final(a, gw, ngw, lane, layer); SEAM(pb + 8); }
        if (INP(9)) { PHASE_BEGIN();
            const bool sw1 = (layer == 0), swfirst = ((bx >> 3) & 1) != 0;
            if (sw1 && swfirst) shiftw_phase(a, 1, lds, tid, gw, ngw, lane);
            pg8::Gemm g{(const char*)U, (const char*)(wb + W_IN + (size_t)NZS * DM * 2), DM, DM, DM}; pg8::Order<4> S; S.ragged = false; S.lda2 = 0; S.so.init(layer == 1 ? ML : MT, NGC, G, bx, WGM_G3, ((REVMASK >> 4) & 1) ^ (layer & REVLAYER)); S.pm0 = layer == 1 ? 4 : 0; S.lda2 = DM * 2;
            pg8::EpiGate8 E{(unsigned char*)(zb + Z_G), SSQ + (size_t)(layer * 3 + 1) * MT, SW + (size_t)1 * 5 * SWLD + NZS, a.b_merge + (size_t)layer * 3 * DM};
            pg8::gemm_phase(lds, g, S, E, tid); if ((DUPMASK >> 9) & 1) { asm volatile("" : "+v"(tid)); pg8::gemm_phase(lds, g, S, E, tid); }
            asm volatile("" : "+v"(tid)); pg8::gemm_phase<pg8::EpiGate8, pg8::Order<4>, 2>(lds, g, S, E, tid);
            if (sw1 && !swfirst) shiftw_phase(a, 1, lds, tid, gw, ngw, lane);
            SEAM(pb + 9);
        }
        if (INP(10)) { PHASE_BEGIN();
            pg8::Gemm g{(const char*)(cb + C_YS), (const char*)(wb + W_BR), 3072, 1024, 1024}; pg8::Order<2> S; S.ragged = false; S.lda2 = 3072 * 2; S.so.init(layer == 1 ? ML : MT, DM, G, bx, WGM_G4, ((REVMASK >> 5) & 1) ^ (layer & REVLAYER)); S.pm0 = layer == 1 ? 4 : 0;
            pg8::EpiMerge E{(const unsigned char*)(zb + Z_G), MG};
            pg8::gemm_phase(lds, g, S, E, tid); if ((DUPMASK >> 10) & 1) { asm volatile("" : "+v"(tid)); pg8::gemm_phase(lds, g, S, E, tid); }
            asm volatile("" : "+v"(tid)); pg8::gemm_phase<pg8::EpiMerge, pg8::Order<2>, 2>(lds, g, S, E, tid);
            SEAM(pb + 10);
        }
        if (INP(11)) { PHASE_BEGIN();
            pg8::Gemm g{(const char*)MG, (const char*)(wb + W_OUT), DM, DM, DM}; pg8::Order<3> S; S.ragged = (G == 256 && layer == 0); S.lda2 = DM * 2; S.so.init(layer == 1 || S.ragged ? ML : MT, DM, G, bx, WGM_G5, ((REVMASK >> 6) & 1) ^ (layer & REVLAYER)); S.pm0 = layer == 1 ? 4 : 0;
            pg8::EpiResid E{U, modl + 5 * DM, a.norm_g + (size_t)(layer * 3 + 1) * DM, modl + 4 * DM, a.norm_g + (size_t)(layer * 3 + 2) * DM, modl + 7 * DM, SSQ + (size_t)(layer * 3 + 2) * MT, 1.0f};
            pg8::gemm_phase(lds, g, S, E, tid);
            { pg8::OrderQ SQ{bx, DM * 2, S.ragged}; asm volatile("" : "+v"(tid)); pg8::gemm_phase<pg8::EpiResid, pg8::OrderQ, 1>(lds, g, SQ, E, tid); }
            SEAM(pb + 11);
        }
        if (INP(13)) { PHASE_BEGIN();
            pg8::Gemm g{(const char*)U, (const char*)(wb + W_13B), DM, DM, DM}; pg8::Order<4> S; S.ragged = false; S.lda2 = 0; S.so.init(layer == 1 ? ML : MT, 2 * DFF, G, bx, WGM_G1, ((REVMASK >> 7) & 1) ^ (layer & REVLAYER)); S.pm0 = layer == 1 ? 4 : 0; S.lda2 = DM * 2;
            pg8::EpiSwiglu E{(bf16_t*)(zb + Z_ACT), SSQ + (size_t)(layer * 3 + 2) * MT, SW + (size_t)2 * 5 * SWLD};
            pg8::gemm_phase(lds, g, S, E, tid); if ((DUPMASK >> 13) & 1) { asm volatile("" : "+v"(tid)); pg8::gemm_phase(lds, g, S, E, tid); }
            asm volatile("" : "+v"(tid)); pg8::gemm_phase<pg8::EpiSwiglu, pg8::Order<4>, 2>(lds, g, S, E, tid);
            SEAM(pb + 13);
        }
        if (INP(14)) { PHASE_BEGIN();
            pg8::Gemm g{(const char*)(zb + Z_ACT), (const char*)(wb + W_2B), DFF, DFF, DFF}; pg8::Order<3> S; S.ragged = (G == 256 && layer == 0); S.lda2 = DFF * 2; S.so.init(layer == 1 || S.ragged ? ML : MT, DM, G, bx, WGM_G2, ((REVMASK >> 8) & 1) ^ (layer & REVLAYER)); S.pm0 = layer == 1 ? 4 : 0;
            pg8::EpiResid E{U, modl + 8 * DM, a.norm_g + (size_t)(layer * 3 + 2) * DM, modl + 7 * DM, layer == 0 ? a.norm_g + (size_t)3 * DM : (const float*)nullptr, modl + 5 * (NMOD * DM) + 1 * DM, SSQ + (size_t)3 * MT, 0.5f};
            pg8::gemm_phase(lds, g, S, E, tid);
            { pg8::OrderQ SQ{bx, DFF * 2, S.ragged}; asm volatile("" : "+v"(tid)); pg8::gemm_phase<pg8::EpiResid, pg8::OrderQ, 1>(lds, g, SQ, E, tid); }
            SEAM(pb + 14);
        }
    }
    if (((ENMASK >> 16) & 1) && IN(31)) {
        const int layer = 1; PHASE_BEGIN();
        f32x4 gq[8];
        { const f32x4* gp = (const f32x4*)a.final_norm_g + lane;
#pragma unroll
          for (int j = 0; j < 8; ++j) gq[j] = gp[64 * j]; }
        for (int m = gw; m < ML; m += ngw) {
            const u32x2* hr = (const u32x2*)(U + (size_t)(MC + m) * DM) + lane; f32x4* xr = (f32x4*)(a.out + (size_t)m * DM) + lane;
            f32x4 x[8]; float ss = 0.f;
#pragma unroll
            for (int j = 0; j < 8; ++j) { const u32x2 w = hr[64 * j]; x[j] = (f32x4){bflo(w.x), bfhi(w.x), bflo(w.y), bfhi(w.y)}; ss += (x[j].x * x[j].x + x[j].y * x[j].y) + (x[j].z * x[j].z + x[j].w * x[j].w); }
            const float rstd = 1.0f / sqrtf(wave_sum(ss) * (1.0f / DM) + EPS);
#pragma unroll
            for (int j = 0; j < 8; ++j) xr[64 * j] = (x[j] * rstd) * gq[j];
        }
    }
#undef IN
#undef INP
#undef SEAM
}

extern "C" void kernel_launch(void* const* d_in, const int* in_sizes, int n_in, void* d_out, int out_size, void* d_ws, size_t ws_size, hipStream_t stream) {
    static int grid = 0;
    if (grid == 0) {
        if (n_in != 25 || out_size != ML * DM || ws_size < WS_END) { fprintf(stderr, "kernel_launch: unexpected shapes (n_in %d, out %d, ws %zu, need %zu)\n", n_in, out_size, ws_size, (size_t)WS_END); grid = -1; return; }
        int dev = 0, cus = 0;
        if (hipGetDevice(&dev) != hipSuccess || hipDeviceGetAttribute(&cus, hipDeviceAttributeMultiprocessorCount, dev) != hipSuccess) { grid = -1; return; }
        if (hipFuncSetAttribute((const void*)fwd_kernel, hipFuncAttributeMaxDynamicSharedMemorySize, LDS_BYTES) != hipSuccess) { fprintf(stderr, "kernel_launch: hipFuncSetAttribute failed\n"); grid = -1; return; }
        int per_cu = 0;
        if (hipOccupancyMaxActiveBlocksPerMultiprocessor(&per_cu, (const void*)fwd_kernel, NWAVES * 64, LDS_BYTES) != hipSuccess || per_cu < 1) { fprintf(stderr, "kernel_launch: occupancy query reports %d\n", per_cu); }
        (void)hipGetLastError();
        grid = cus;
    }
    if (grid < 0) return;
    (void)hipMemsetAsync((char*)d_ws + WS_CTL, 0, CTL_ZERO_BYTES, stream);
    Args a{};
    const float** p = (const float**)&a;
    for (int i = 0; i < 25; ++i) p[i] = (const float*)d_in[i];
    a.out = (float*)d_out; a.ws = (unsigned char*)d_ws;
#if MK_ONE_LAUNCH
    a.ph_lo = 0; a.ph_hi = NPH;
    hipLaunchKernelGGL(fwd_kernel, dim3(grid), dim3(NWAVES * 64), LDS_BYTES, stream, a);
#else
    for (int ph = 0; ph < NPH; ++ph) { a.ph_lo = ph; a.ph_hi = ph + 1; hipLaunchKernelGGL(fwd_kernel, dim3(grid), dim3(NWAVES * 64), LDS_BYTES, stream, a); }
#endif
}
```

```cpp
#include <hip/hip_runtime.h>
#include <cstdio>
#include <cstdint>

#ifndef MK_ONE_LAUNCH
#define MK_ONE_LAUNCH 1
#endif

#define LAS __attribute__((address_space(3)))
#define GAS __attribute__((address_space(1)))
typedef unsigned short bf16_t;
typedef short bf16x8 __attribute__((ext_vector_type(8)));
typedef short s16x4 __attribute__((ext_vector_type(4)));
typedef float f32x4 __attribute__((ext_vector_type(4)));
typedef float f32x2 __attribute__((ext_vector_type(2)));
typedef float f32x16 __attribute__((ext_vector_type(16)));
typedef unsigned u32x4 __attribute__((ext_vector_type(4)));
typedef unsigned u32x2 __attribute__((ext_vector_type(2)));

constexpr int DM = 2048, NB = 4, SEQ = 8192, CTXL = 256, DFF = 5504, NMOD = 9;
constexpr int MC = NB * CTXL;
constexpr int ML = NB * SEQ;
constexpr int MT = MC + ML;
constexpr int NZS = 6656, NGC = 6144, SWLD = 12800;
constexpr int INC = 12800;
constexpr int NCHUNK = MT / 128;
constexpr int SEQV = CTXL + SEQ;
constexpr float EPS = 1e-6f;
constexpr float LOG2E = 1.4426950408889634f;

constexpr size_t MiB = 1u << 20;
constexpr size_t WS_CTL = 0, CTL_ZERO_BYTES = 4 * MiB;
constexpr size_t WS_SSQ = 1 * MiB;
constexpr size_t WS_MOD = 4 * MiB;
constexpr size_t WS_ROPE = 5 * MiB + 65536;
constexpr size_t WS_C8 = 5 * MiB;
constexpr size_t WS_SW = 6 * MiB;
constexpr size_t WS_SUMM = 8 * MiB;
constexpr size_t WS_CARRY = 16 * MiB + 512 * 1024;
constexpr size_t WS_W = 19 * MiB;
constexpr size_t W_13 = 0, W_2 = W_13 + (size_t)2 * DFF * DM * 2, W_IN = W_2 + (size_t)DM * DFF * 2, W_GAT = W_IN + (size_t)INC * DM * 2,
                 W_BR = W_GAT + (size_t)4096 * 256 * 2, W_OUT = W_BR + (size_t)3 * DM * 1024 * 2, W_13B = W_OUT + (size_t)DM * DM * 2,
                 W_2B = W_13B + (size_t)2 * DFF * DM * 2, W_END = W_2B + (size_t)DM * DFF * 2;
constexpr size_t W_REGION = ((W_END + MiB - 1) / MiB) * MiB;
constexpr size_t WS_H = WS_W + 2 * W_REGION;
constexpr size_t WS_Z = WS_H + (size_t)MT * 4096;
constexpr size_t WS_CR = WS_Z + (size_t)MT * 13312;
constexpr size_t WS_END = WS_CR + (size_t)MT * 11264;
static_assert(WS_END <= (size_t)1418084416, "workspace map exceeds the guaranteed scratch size (sum of the inputs)");
constexpr size_t Z_ACT = 0;
constexpr size_t Z_RX = 0, Z_RG = (size_t)MT * 2048, Z_S3 = (size_t)MT * 4096, Z_Q = (size_t)MT * 10240, Z_KV = (size_t)MT * 12288;
constexpr size_t Z_LA = Z_S3;
constexpr size_t Z_UU = Z_S3 + (size_t)MT * 4096;
constexpr size_t Z_G = 0;
constexpr size_t C_UB = 0;
constexpr size_t C_XA = 0, C_YS = (size_t)MT * 2048, C_QR = (size_t)MT * 8192, C_KR = (size_t)MT * 10240, C_VT = (size_t)MT * 10752;
constexpr int CW_BAR = 4096;

__device__ __forceinline__ size_t zt(int m, int c) { return (size_t)(c >> 8) * ((size_t)MT * 256) + (size_t)m * 256 + (c & 255); }
__device__ __forceinline__ unsigned pk2(float lo, float hi) {
    typedef float f2_t __attribute__((ext_vector_type(2))); typedef __bf16 b2_t __attribute__((ext_vector_type(2)));
    f2_t v = {lo, hi}; b2_t b = __builtin_convertvector(v, b2_t); return __builtin_bit_cast(unsigned, b);
}
__device__ __forceinline__ float bflo(unsigned w) { return __uint_as_float(w << 16); }
__device__ __forceinline__ float bfhi(unsigned w) { return __uint_as_float(w & 0xffff0000u); }
__device__ __forceinline__ float wave_sum(float v) {
#pragma unroll
    for (int o = 1; o < 64; o <<= 1) v += __shfl_xor(v, o);
    return v;
}
__device__ __forceinline__ void unpack8(const u32x4 w, float (&f)[8]) { f[0] = bflo(w.x); f[1] = bfhi(w.x); f[2] = bflo(w.y); f[3] = bfhi(w.y); f[4] = bflo(w.z); f[5] = bfhi(w.z); f[6] = bflo(w.w); f[7] = bfhi(w.w); }
__device__ __forceinline__ u32x4 pack8(const float (&f)[8]) { u32x4 w; w.x = pk2(f[0], f[1]); w.y = pk2(f[2], f[3]); w.z = pk2(f[4], f[5]); w.w = pk2(f[6], f[7]); return w; }
__device__ __forceinline__ float sigmoidf_(float x) { return __builtin_amdgcn_rcpf(1.0f + __expf(-x)); }

#ifndef HALFCTX
#define HALFCTX 1
#endif
namespace pg8 {
constexpr int BM = 256, BK = 64, HALF = 128, HTB = HALF * BK * 2, STAGE_BYTES = 8 * HTB, NXCD = 8;
__host__ __device__ __forceinline__ int lds_byte(int r, int c) { const int st = (r >> 4) * 2 + (c >> 5), rr = r & 15, cc = c & 31, ob = rr * 64 + cc * 2; return st * 1024 + (ob ^ (((ob >> 9) & 1) << 5)); }
__host__ __device__ __forceinline__ void stage_rc(int b, int& R, int& C) { const int st = b / 1024, sb = b % 1024, swz = sb ^ (((sb >> 9) & 1) << 5); R = (st >> 1) * 16 + swz / 64; C = (st & 1) * 32 + (swz % 64) / 2; }
__host__ __device__ __forceinline__ int perm32(int rho) { const int n = rho >> 4, i = rho & 15; return 8 * (i >> 2) + 4 * n + (i & 3); }

struct Unit { int pm, pn; unsigned aoff, boff; int seg, keep; };
struct Gemm { const char* A; const char* Bt; int lda, ldb, K; };

struct StaticOrder {
    int nM, nN, nwg, G, c, WGM, rev;
    __host__ __device__ void init(int M, int N, int G_, int c_, int wgm = 4, int rev_ = 0) { nM = M / BM; nN = N / BM; nwg = nM * nN; G = G_; c = c_; WGM = wgm; rev = rev_; }
    __host__ __device__ int tail_start() const { const int full = (nwg / G) * G; return (HALFCTX && 2 * (nwg - full) <= G) ? full : nwg; }
    __host__ __device__ bool tile(int i, int& pm, int& pn, int lim) const {
        const long L = (long)i * G + c; if (L >= lim) return false;
        tileL((int)L, pm, pn); return true;
    }
    __host__ __device__ bool tile(int i, int& pm, int& pn) const { return tile(i, pm, pn, nwg); }
    __host__ __device__ void tileL(int L, int& pm, int& pn) const {
        int wgid = L; { const int q = nwg / NXCD, r = nwg % NXCD, xcd = wgid % NXCD, off = wgid / NXCD; wgid = (xcd < r ? xcd * (q + 1) : r * (q + 1) + (xcd - r) * q) + off; }
        const int nig = WGM * nN, gid = wgid / nig, fm = gid * WGM, gsz = (nM - fm) < WGM ? (nM - fm) : WGM;
        pm = fm + ((wgid % nig) % gsz); pn = (wgid % nig) / gsz; if (rev) pm = nM - 1 - pm;
    }
};
template <int MODE> struct Order {
    static constexpr bool QUARTER = (MODE == 3);
    StaticOrder so; int pm0;
    __device__ __forceinline__ bool next_tail(int i, Unit& u) const {
        const int L = so.tail_start() + (so.c >> 1);
        if (i > (MODE == 2 ? 2 : 0) || L >= so.nwg) return false;
        so.tileL(L, u.pm, u.pn); u.pm += pm0;
        const int h = so.c & 1;
        if (MODE == 2) { u.seg = i + 4 * (1 + h); u.keep = i < 2; u.boff = (unsigned)i * (unsigned)(DM * 1024 * 2); u.aoff = (unsigned)i * 2048u + (unsigned)(HALF * h) * (unsigned)lda2; return true; }
        u.seg = 1 + h; u.keep = 0; u.boff = 0u; u.aoff = (unsigned)(HALF * h) * (unsigned)lda2; return true;
    }
    bool ragged; int lda2;
    __device__ __forceinline__ bool next(int i, Unit& u) const {
        if (MODE == 2) { const int ti = i / 3, seg = i - 3 * ti; if (!so.tile(ti, u.pm, u.pn, so.tail_start())) return false; u.pm += pm0;
            u.aoff = (unsigned)seg * 2048u; u.boff = (unsigned)seg * (unsigned)(DM * 1024 * 2); u.seg = seg; u.keep = seg < 2; return true; }
        if (MODE == 3 && ragged) {
            if (i >= 4 || !so.tile(i, u.pm, u.pn)) return false; u.pm += 4; u.seg = 0; u.keep = 0; u.boff = 0u; u.aoff = 0u; return true;
        }
        if (!so.tile(i, u.pm, u.pn, MODE == 4 ? so.tail_start() : so.nwg)) return false; u.pm += pm0;
        u.seg = 0; u.keep = 0; u.boff = 0u; u.aoff = (MODE == 1) ? (unsigned)((u.pn & 7) * 256) : 0u; return true;
    }
};

struct OrderQ {
    int c, lda2; bool on;
    __device__ __forceinline__ bool next(int i, Unit& u) const {
        if (!on || i > 0 || c >= 128) return false;
        u.pn = c & 7; const int qi = (c >> 3) & 3; u.pm = c >> 5; u.seg = 1 + qi; u.keep = 0; u.boff = 0u; u.aoff = (unsigned)(64 * qi) * (unsigned)lda2; return true;
    }
};
template <class Epi, class Sched, int QV = 0>
__device__ __forceinline__ void gemm_phase(LAS unsigned char* lds, const Gemm g, const Sched& S, const Epi& E, const int tid) {
    const int wid = __builtin_amdgcn_readfirstlane(tid >> 6), lane = tid & 63, wr = wid >> 2, wc = wid & 3, fr = lane & 15, fq = lane >> 4;
    const int nt = g.K / BK;
    unsigned voffA[2], voffB[2];
#pragma unroll
    for (int i = 0; i < 2; ++i) { int R, C; stage_rc(tid * 16 + i * 8192, R, C); const int Rb = Epi::PERM ? ((R & ~31) + perm32(R & 31)) : R;
        voffA[i] = (unsigned)(R * g.lda + C) * 2u; voffB[i] = (unsigned)(Rb * g.ldb + C) * 2u; }
    const __amdgpu_buffer_rsrc_t rsA = __builtin_amdgcn_make_buffer_rsrc((void*)g.A, (short)0, (int)0x7fffffff, 0x00020000);
    const __amdgpu_buffer_rsrc_t rsB = __builtin_amdgcn_make_buffer_rsrc((void*)g.Bt, (short)0, (int)0x7fffffff, 0x00020000);
    const unsigned kstep = (unsigned)(BK * 2);
    const unsigned hstepA = (unsigned)HALF * (unsigned)g.lda * 2u, hstepB = (unsigned)HALF * (unsigned)g.ldb * 2u;
    const unsigned tstepA = 2u * hstepA, tstepB = 2u * hstepB;
    const unsigned ldsw = (unsigned)wid * 1024u;
    const int aoff = lds_byte(wr * 64 + fr, fq * 8), boff = lds_byte(wc * 32 + fr, fq * 8);
#define PG8_SA(b, h) (((b) * 2 + (h)) * HTB)
#define PG8_SB(b, h) ((4 + (b) * 2 + (h)) * HTB)
#define PG8_STAGEX(rs, bufoff, soff, voff) do { _Pragma("unroll") for (int _i = 0; _i < 2; ++_i) \
        __builtin_amdgcn_raw_ptr_buffer_load_lds(rs, (LAS unsigned*)(lds + (bufoff) + ldsw + _i * 8192), 16, (voff)[_i], (soff), 0, 0); } while (0)
#define PG8_LDA(dst, b, h) do { _Pragma("unroll") for (int m = 0; m < 4; ++m) _Pragma("unroll") for (int k = 0; k < 2; ++k) dst[m][k] = *(const LAS bf16x8*)(lds + PG8_SA(b, h) + aoff + m * 2048 + k * 1024); } while (0)
#define PG8_LDB(dst, b, h) do { _Pragma("unroll") for (int n = 0; n < 2; ++n) _Pragma("unroll") for (int k = 0; k < 2; ++k) dst[n][k] = *(const LAS bf16x8*)(lds + PG8_SB(b, h) + boff + n * 2048 + k * 1024); } while (0)
#define PG8_MMA(ai, bj, At, Bt) do { __builtin_amdgcn_s_setprio(1); _Pragma("unroll") for (int m = 0; m < 4; ++m) _Pragma("unroll") for (int n = 0; n < 2; ++n) _Pragma("unroll") for (int k = 0; k < 2; ++k) \
        acc[ai][bj][m][n] = Epi::SWAP ? __builtin_amdgcn_mfma_f32_16x16x32_bf16(At[m][k], Bt[n][k], acc[ai][bj][m][n], 0, 0, 0) : __builtin_amdgcn_mfma_f32_16x16x32_bf16(Bt[n][k], At[m][k], acc[ai][bj][m][n], 0, 0, 0); __builtin_amdgcn_s_setprio(0); } while (0)
#define PG8_WAIT_V(n) asm volatile("s_waitcnt vmcnt(" #n ")" ::: "memory")
#define PG8_WAIT_L(n) asm volatile("s_waitcnt lgkmcnt(" #n ")" ::: "memory")
#define PG8_BAR __builtin_amdgcn_s_barrier()
#define PG8_SCHED __builtin_amdgcn_sched_barrier(0)
    Unit cur, nxt; int ui = 0;
    if constexpr (QV == 2) { if (!S.next_tail(0, cur)) return; } else { if (!S.next(0, cur)) return; }
    f32x4 acc[2][2][4][2];
#pragma unroll
    for (int a = 0; a < 2; ++a)
#pragma unroll
        for (int b = 0; b < 2; ++b)
#pragma unroll
            for (int m = 0; m < 4; ++m)
#pragma unroll
                for (int n = 0; n < 2; ++n) { f32x2 z0, z1; asm("v_mov_b64 %0, 0\n\tv_mov_b64 %1, 0" : "=v"(z0), "=v"(z1));
                    acc[a][b][m][n] = __builtin_shufflevector(z0, z1, 0, 1, 2, 3); }
    bf16x8 At[4][2], B0[2][2], B1[2][2];
    unsigned cA = (unsigned)cur.pm * tstepA + cur.aoff, cB = (unsigned)cur.pn * tstepB + cur.boff;
    PG8_STAGEX(rsB, PG8_SB(0, 0), cB, voffB); PG8_STAGEX(rsB, PG8_SB(0, 1), cB + hstepB, voffB); PG8_STAGEX(rsA, PG8_SA(0, 0), cA, voffA); PG8_STAGEX(rsA, PG8_SA(0, 1), cA + hstepA, voffA);
    if (wr == 1) PG8_BAR;
    PG8_WAIT_V(2); PG8_BAR;
    PG8_STAGEX(rsB, PG8_SB(1, 0), cB + kstep, voffB); PG8_STAGEX(rsA, PG8_SA(1, 0), cA + kstep, voffA); PG8_STAGEX(rsB, PG8_SB(1, 1), cB + hstepB + kstep, voffB);
    PG8_WAIT_V(6); PG8_BAR;
    for (;;) {
        bool has_next; if constexpr (QV == 2) has_next = S.next_tail(ui + 1, nxt); else has_next = S.next(ui + 1, nxt);
        const unsigned nA = has_next ? (unsigned)nxt.pm * tstepA + nxt.aoff : cA, nB = has_next ? (unsigned)nxt.pn * tstepB + nxt.boff : cB;
        if constexpr (QV == 0) {
#pragma nounroll
        for (int t = 0; t < nt; t += 2) {
            const bool last = (t == nt - 2);
            const unsigned a1 = cA + (unsigned)(t + 1) * kstep;
            const unsigned a2 = last ? nA : cA + (unsigned)(t + 2) * kstep, b2 = last ? nB : cB + (unsigned)(t + 2) * kstep;
            const unsigned a3 = a2 + kstep, b3 = b2 + kstep;
            PG8_LDB(B0, 0, 0); PG8_LDB(B1, 0, 1); PG8_SCHED; PG8_LDA(At, 0, 0); PG8_STAGEX(rsA, PG8_SA(1, 1), a1 + hstepA, voffA);
            PG8_WAIT_V(8); PG8_WAIT_L(0); PG8_BAR; PG8_MMA(0, 0, At, B0); PG8_MMA(0, 1, At, B1); PG8_BAR; PG8_SCHED;
            PG8_LDA(At, 0, 1); PG8_STAGEX(rsB, PG8_SB(0, 0), b2, voffB); PG8_STAGEX(rsB, PG8_SB(0, 1), b2 + hstepB, voffB); PG8_STAGEX(rsA, PG8_SA(0, 0), a2, voffA);
            PG8_WAIT_V(8); PG8_WAIT_L(0); PG8_BAR; PG8_MMA(1, 0, At, B0); PG8_MMA(1, 1, At, B1); PG8_BAR; PG8_SCHED;
            PG8_LDB(B0, 1, 0); PG8_LDB(B1, 1, 1); PG8_SCHED; PG8_LDA(At, 1, 0); PG8_STAGEX(rsA, PG8_SA(0, 1), a2 + hstepA, voffA);
            PG8_WAIT_V(8); PG8_WAIT_L(0); PG8_BAR; PG8_MMA(0, 0, At, B0); PG8_MMA(0, 1, At, B1); PG8_BAR; PG8_SCHED;
            PG8_LDA(At, 1, 1); PG8_STAGEX(rsB, PG8_SB(1, 0), b3, voffB); PG8_STAGEX(rsB, PG8_SB(1, 1), b3 + hstepB, voffB); PG8_STAGEX(rsA, PG8_SA(1, 0), a3, voffA);
            PG8_WAIT_V(8); PG8_WAIT_L(0); PG8_BAR; PG8_MMA(1, 0, At, B0); PG8_MMA(1, 1, At, B1); PG8_BAR; PG8_SCHED;
        }
        } else {
            const bool w0 = (QV == 2) || (wr == 0);
#pragma nounroll
            for (int t = 0; t < nt; t += 2) {
                const bool last = (t == nt - 2);
                const unsigned a1 = cA + (unsigned)(t + 1) * kstep;
                const unsigned a2 = last ? nA : cA + (unsigned)(t + 2) * kstep, b2 = last ? nB : cB + (unsigned)(t + 2) * kstep;
                const unsigned a3 = a2 + kstep, b3 = b2 + kstep;
                if (w0) { PG8_LDB(B0, 0, 0); PG8_LDB(B1, 0, 1); PG8_SCHED; PG8_LDA(At, 0, 0); }
                PG8_WAIT_L(0); PG8_BAR; if (w0) { PG8_MMA(0, 0, At, B0); PG8_MMA(0, 1, At, B1); } PG8_BAR; PG8_SCHED;
                PG8_STAGEX(rsB, PG8_SB(0, 0), b2, voffB); PG8_STAGEX(rsB, PG8_SB(0, 1), b2 + hstepB, voffB); PG8_STAGEX(rsA, PG8_SA(0, 0), a2, voffA);
                PG8_WAIT_V(6); PG8_BAR; PG8_BAR; PG8_SCHED;
                if (w0) { PG8_LDB(B0, 1, 0); PG8_LDB(B1, 1, 1); PG8_SCHED; PG8_LDA(At, 1, 0); }
                PG8_WAIT_L(0); PG8_BAR; if (w0) { PG8_MMA(0, 0, At, B0); PG8_MMA(0, 1, At, B1); } PG8_BAR; PG8_SCHED;
                PG8_STAGEX(rsB, PG8_SB(1, 0), b3, voffB); PG8_STAGEX(rsB, PG8_SB(1, 1), b3 + hstepB, voffB); PG8_STAGEX(rsA, PG8_SA(1, 0), a3, voffA);
                PG8_WAIT_V(6); PG8_BAR; PG8_BAR; PG8_SCHED;
            }
        }
        if (wr == 0) PG8_BAR;
        E.template run<QV>(acc, cur, wr, wc, fr, fq);
        if (!has_next) break;
        if (!cur.keep) {
#pragma unroll
            for (int a = 0; a < 2; ++a)
#pragma unroll
                for (int b = 0; b < 2; ++b)
#pragma unroll
                    for (int m = 0; m < 4; ++m)
#pragma unroll
                        for (int n = 0; n < 2; ++n) { f32x2 z0, z1; asm("v_mov_b64 %0, 0\n\tv_mov_b64 %1, 0" : "=v"(z0), "=v"(z1));
                    acc[a][b][m][n] = __builtin_shufflevector(z0, z1, 0, 1, 2, 3); }
        }
        cur = nxt; cA = nA; cB = nB; ++ui;
        if (wr == 1) PG8_BAR;
    }
    PG8_WAIT_V(0);
    PG8_BAR;
#undef PG8_SA
#undef PG8_SB
#undef PG8_STAGEX
#undef PG8_LDA
#undef PG8_LDB
#undef PG8_MMA
#undef PG8_WAIT_V
#undef PG8_WAIT_L
#undef PG8_BAR
#undef PG8_SCHED
}

constexpr float SSQ_SCALE = 1048576.0f;
__device__ __forceinline__ void row_rstd(const unsigned long long* ssq, int row0, float (&rs)[2][4]) {
    unsigned long long q[2][4];
#pragma unroll
    for (int ai = 0; ai < 2; ++ai)
#pragma unroll
        for (int m = 0; m < 4; ++m) q[ai][m] = ssq[row0 + ai * HALF + m * 16];
    asm volatile("" : "+v"(q[0][0]), "+v"(q[0][1]), "+v"(q[0][2]), "+v"(q[0][3]), "+v"(q[1][0]), "+v"(q[1][1]), "+v"(q[1][2]), "+v"(q[1][3]));
#pragma unroll
    for (int ai = 0; ai < 2; ++ai)
#pragma unroll
        for (int m = 0; m < 4; ++m) {
            const float qf = __builtin_fmaf((float)(unsigned)(q[ai][m] >> 32), 4294967296.0f, (float)(unsigned)q[ai][m]);
            rs[ai][m] = __builtin_amdgcn_rsqf(__builtin_fmaf(qf, 1.0f / (SSQ_SCALE * DM), EPS)); }
}
struct EpiStore {
    static constexpr bool PERM = true; static constexpr bool SWAP = false;
    bf16_t* O; int ld; size_t tstride; const unsigned long long* ssq; const float* sw;
    bf16_t* QR; bf16_t* KR; const float* rope;
    bf16_t* XA; const float* cw; const float* cbi;
    template <int QVV> __device__ __forceinline__ void run(f32x4 (&acc)[2][2][4][2], const Unit& u, int wr, int wc, int fr, int fq) const {
        constexpr int nai = (QVV == 2) ? 1 : 2; const int r0 = u.pm * BM + (QVV == 2 ? (u.seg - 1) * HALF : 0);
        char* tb = (char*)(O + (size_t)u.pn * tstride + (size_t)r0 * ld);
        const int v = u.pm < 4 ? 4 : ((u.pm - 4) >> 5);
        const char* swb = (const char*)(sw + (size_t)v * SWLD + u.pn * BM);
        unsigned lo = (unsigned)((wr * 64 + fr) * ld + wc * 32 + 8 * fq) * 2u;
        unsigned co = (unsigned)(wc * 32 + 8 * fq) * 4u;
        const unsigned rs_ = (unsigned)ld * 2u;
        asm volatile("" : "+v"(lo), "+v"(co));
        const f32x4 SW00 = *(const f32x4*)(swb + co), SW01 = *(const f32x4*)(swb + co + 16), SW10 = *(const f32x4*)(swb + co + HALF * 4), SW11 = *(const f32x4*)(swb + co + HALF * 4 + 16);
        float rs[2][4]; row_rstd(ssq, r0 + wr * 64 + fr, rs);
        if (u.pn < 4) {
            const int c0 = u.pn * BM + wc * 32 + 8 * fq;
#pragma unroll
            for (int bj = 0; bj < 2; ++bj) {
                const f32x4 sh[2] = {bj == 0 ? SW00 : SW10, bj == 0 ? SW01 : SW11};
                const float* cwp = cw + c0 + bj * HALF; const float* cbp = cbi + c0 + bj * HALF;
#pragma unroll
                for (int ai = 0; ai < 2; ++ai) { if (ai >= nai) continue;
#pragma unroll
                    for (int n = 0; n < 2; ++n) {
                        const f32x4 w0 = *(const f32x4*)(cwp + 4 * n), w1 = *(const f32x4*)(cwp + 1024 + 4 * n), w2 = *(const f32x4*)(cwp + 2048 + 4 * n), w3 = *(const f32x4*)(cwp + 3072 + 4 * n), bb = *(const f32x4*)(cbp + 4 * n);
                        f32x4 X[4];
#pragma unroll
                        for (int m = 0; m < 4; ++m) X[m] = acc[ai][bj][m][n] * rs[ai][m] + sh[n];
                        if (fr <= 2) *(u32x2*)(tb + lo + (unsigned)(ai * HALF) * rs_ + bj * HALF * 2 + n * 8) = (u32x2){pk2(X[0][0], X[0][1]), pk2(X[0][2], X[0][3])};
                        if (fr >= 13) *(u32x2*)(tb + lo + (unsigned)(ai * HALF + 48) * rs_ + bj * HALF * 2 + n * 8) = (u32x2){pk2(X[3][0], X[3][1]), pk2(X[3][2], X[3][3])};
#pragma unroll
                        for (int m = 0; m < 4; ++m) {
                            const int mp = m > 0 ? m - 1 : 0, mn = m < 3 ? m + 1 : 3;
                            f32x4 o;
#pragma unroll
                            for (int i = 0; i < 4; ++i) {
                                const float xif = X[m][i], xpf = X[mp][i], xnf = X[mn][i];
                                const int xi = __float_as_int(xif), xp = __float_as_int(xpf), xn = __float_as_int(xnf);
                                const float p1 = __builtin_bit_cast(float, __builtin_amdgcn_update_dpp(__builtin_amdgcn_update_dpp(0, xp, 0x121, 0xf, 0xf, false), xi, 0x111, 0xf, 0xf, false));
                                const float p2 = __builtin_bit_cast(float, __builtin_amdgcn_update_dpp(__builtin_amdgcn_update_dpp(0, xp, 0x122, 0xf, 0xf, false), xi, 0x112, 0xf, 0xf, false));
                                const float n1 = __builtin_bit_cast(float, __builtin_amdgcn_update_dpp(__builtin_amdgcn_update_dpp(0, xn, 0x12f, 0xf, 0xf, false), xi, 0x101, 0xf, 0xf, false));
                                o[i] = bb[i] + w0[i] * p2 + w1[i] * p1 + w2[i] * X[m][i] + w3[i] * n1; }
                            const int r = r0 + wr * 64 + fr + ai * HALF + m * 16;
                            const bool edge = (m == 0 && fr < 2) || (m == 3 && fr == 15);
                            if (!edge) *(u32x2*)(XA + (size_t)r * 1024 + c0 + bj * HALF + 4 * n) = (u32x2){pk2(o[0], o[1]), pk2(o[2], o[3])}; }
                    }
                }
            }
            return;
        }
        if (u.pn >= 12 && u.pn < 20) {
            const int j = u.pn - 12;
            char* tp = (char*)(O + (size_t)(12 + (j >> 1)) * tstride + (size_t)r0 * ld) + (j & 1) * 256;
            const f32x4 a0 = SW00, a1 = SW01, b0 = SW10, b1 = SW11;
#pragma unroll
            for (int ai = 0; ai < 2; ++ai)
#pragma unroll
                for (int m = 0; m < 4; ++m) { if (ai >= nai) continue; const unsigned ro = lo + (unsigned)(ai * HALF + m * 16) * rs_;
                    const f32x4 v0 = (acc[ai][0][m][0] * rs[ai][m] + a0) * (acc[ai][1][m][0] * rs[ai][m] + b0), v1 = (acc[ai][0][m][1] * rs[ai][m] + a1) * (acc[ai][1][m][1] * rs[ai][m] + b1);
                    u32x4 w; w.x = pk2(v0[0], v0[1]); w.y = pk2(v0[2], v0[3]); w.z = pk2(v1[0], v1[1]); w.w = pk2(v1[2], v1[3]);
                    *(u32x4*)(tp + ro) = w; }
            return;
        }
        if (u.pn >= 20 && u.pn < 25) {
            const int j = u.pn - 20, sa = wc & 1; const bool isk = (j == 4), ctx = u.pm < 4;
            bf16_t* ob = isk ? KR : QR; const int ldo = isk ? 256 : 1024;
            unsigned oo = (unsigned)((isk ? (wc >> 1) : 2 * j + (wc >> 1)) * 128 + sa * 64 + 8 * fq);
            asm volatile("" : "+v"(oo));
            const f32x4 a0 = SW00, a1 = SW01, b0 = SW10, b1 = SW11;
#pragma unroll
            for (int ai = 0; ai < 2; ++ai)
#pragma unroll
                for (int m = 0; m < 4; ++m) { if (ai >= nai) continue;
                    const int r = r0 + wr * 64 + fr + ai * HALF + m * 16;
                    f32x4 c0 = {1.f, 1.f, 1.f, 1.f}, c1 = c0, s0 = {0.f, 0.f, 0.f, 0.f}, s1 = s0;
                    if (!ctx) { const int t = (r - MC) & 8191, pos = sa ? (t & 63) : (t >> 6); const float* tp = rope + pos * 32 + 8 * fq;
                        c0 = *(const f32x4*)tp; c1 = *(const f32x4*)(tp + 4); s0 = *(const f32x4*)(tp + 4096); s1 = *(const f32x4*)(tp + 4100); }
                    const f32x4 x10 = acc[ai][0][m][0] * rs[ai][m] + a0, x11 = acc[ai][0][m][1] * rs[ai][m] + a1, x20 = acc[ai][1][m][0] * rs[ai][m] + b0, x21 = acc[ai][1][m][1] * rs[ai][m] + b1;
                    const f32x4 p0 = x10 * c0 - x20 * s0, p1 = x11 * c1 - x21 * s1, q0 = x20 * c0 + x10 * s0, q1 = x21 * c1 + x11 * s1;
                    u32x4 w1, w2; w1.x = pk2(p0[0], p0[1]); w1.y = pk2(p0[2], p0[3]); w1.z = pk2(p1[0], p1[1]); w1.w = pk2(p1[2], p1[3]);
                    w2.x = pk2(q0[0], q0[1]); w2.y = pk2(q0[2], q0[3]); w2.z = pk2(q1[0], q1[1]); w2.w = pk2(q1[2], q1[3]);
                    bf16_t* op = ob + (size_t)r * ldo + oo;
                    *(u32x4*)op = w1; *(u32x4*)(op + 32) = w2; }
            return;
        }
#pragma unroll
        for (int bj = 0; bj < 2; ++bj) { const f32x4 s0 = bj == 0 ? SW00 : SW10, s1 = bj == 0 ? SW01 : SW11;
#pragma unroll
            for (int ai = 0; ai < 2; ++ai)
#pragma unroll
                for (int m = 0; m < 4; ++m) { if (ai >= nai) continue; const unsigned ro = lo + (unsigned)(ai * HALF + m * 16) * rs_;
                    const f32x4 v0 = acc[ai][bj][m][0] * rs[ai][m] + s0, v1 = acc[ai][bj][m][1] * rs[ai][m] + s1;
                    u32x4 w; w.x = pk2(v0[0], v0[1]); w.y = pk2(v0[2], v0[3]); w.z = pk2(v1[0], v1[1]); w.w = pk2(v1[2], v1[3]);
                    *(u32x4*)(tb + ro + bj * HALF * 2) = w; } }
    }
};
struct EpiSwiglu {
    static constexpr bool PERM = true; static constexpr bool SWAP = false;
    bf16_t* O; const unsigned long long* ssq; const float* sw;
    template <int QVV> __device__ __forceinline__ void run(f32x4 (&acc)[2][2][4][2], const Unit& u, int wr, int wc, int fr, int fq) const {
        constexpr int nai = (QVV == 2) ? 1 : 2; const int r0 = u.pm * BM + (QVV == 2 ? (u.seg - 1) * HALF : 0);
        char* tb = (char*)(O + (size_t)r0 * DFF + u.pn * HALF);
        const int v = u.pm < 4 ? 4 : ((u.pm - 4) >> 5);
        const char* swb = (const char*)(sw + (size_t)v * SWLD + u.pn * BM);
        unsigned lo = (unsigned)((wr * 64 + fr) * DFF + wc * 32 + 8 * fq) * 2u;
        unsigned co = (unsigned)(wc * 32 + 8 * fq) * 4u;
        asm volatile("" : "+v"(lo), "+v"(co));
        f32x4 sg[2], su[2], sgn[2];
#pragma unroll
        for (int n = 0; n < 2; ++n) { sg[n] = *(const f32x4*)(swb + co + n * 16); su[n] = *(const f32x4*)(swb + co + HALF * 4 + n * 16); }
        float rs[2][4]; row_rstd(ssq, r0 + wr * 64 + fr, rs);
#pragma unroll
        for (int n = 0; n < 2; ++n) sgn[n] = sg[n] * (-LOG2E);
#pragma unroll
        for (int ai = 0; ai < 2; ++ai)
#pragma unroll
            for (int m = 0; m < 4; ++m) { if (ai >= nai) continue;
                const float r = rs[ai][m], rn = r * (-LOG2E);
                f32x4 o[2];
#pragma unroll
                for (int n = 0; n < 2; ++n) {
                    const f32x4 gt = acc[ai][0][m][n] * r + sg[n], up = acc[ai][1][m][n] * r + su[n], ex = acc[ai][0][m][n] * rn + sgn[n];
                    f32x4 den, rc;
#pragma unroll
                    for (int i = 0; i < 4; ++i) den[i] = __builtin_amdgcn_exp2f(ex[i]);
                    den = den + 1.0f;
#pragma unroll
                    for (int i = 0; i < 4; ++i) rc[i] = __builtin_amdgcn_rcpf(den[i]);
                    o[n] = (gt * up) * rc; }
                u32x4 w; w.x = pk2(o[0][0], o[0][1]); w.y = pk2(o[0][2], o[0][3]); w.z = pk2(o[1][0], o[1][1]); w.w = pk2(o[1][2], o[1][3]);
                *(u32x4*)(tb + lo + (unsigned)(ai * HALF + m * 16) * (DFF * 2)) = w; }
    }
};
struct EpiResid {
    static constexpr bool PERM = true; static constexpr bool SWAP = false;
    bf16_t* S; const float* gate;
    const float* pg; const float* psc; const float* ng; const float* nsc; unsigned long long* ssq;
    float fac;
    template <int QVV> __device__ __forceinline__ void run(f32x4 (&acc)[2][2][4][2], const Unit& u, int wr, int wc, int fr, int fq) const {
        const bool qm = u.seg != 0; const int rq = qm ? 64 * (u.seg - 1) : 0;
        const bool active = !(qm && wr == 1);
        const int v = u.pm < 4 ? 4 : ((u.pm - 4) >> 5);
        char* sb = (char*)(S + ((size_t)u.pm * BM + rq) * DM + u.pn * BM);
        const char* gp = (const char*)(gate + (size_t)v * (NMOD * DM) + u.pn * BM);
        const bool hasn = ng != nullptr;
        const char* pgp = (const char*)(pg + u.pn * BM); const char* psp = (const char*)(psc + (size_t)v * (NMOD * DM) + u.pn * BM);
        const char* ngp = (const char*)(ng + u.pn * BM); const char* nsp = (const char*)(nsc + (size_t)v * (NMOD * DM) + u.pn * BM);
        unsigned co = (unsigned)(wc * 32 + 8 * fq);
        asm volatile("" : "+v"(co));
        unsigned lo = ((unsigned)((wr * 64 + fr) * DM) + co) * 2u;
        asm volatile("" : "+v"(lo));
        if (active) {
        float ss[2][4];
#pragma unroll
        for (int ai = 0; ai < 2; ++ai)
#pragma unroll
            for (int m = 0; m < 4; ++m) ss[ai][m] = 0.f;
#pragma unroll
        for (int bj = 0; bj < 2; ++bj) {
            const unsigned cb4 = (co + bj * HALF) * 4u;
            f32x4 vg0 = *(const f32x4*)(gp + cb4), vg1 = *(const f32x4*)(gp + cb4 + 16), vp0 = *(const f32x4*)(pgp + cb4), vp1 = *(const f32x4*)(pgp + cb4 + 16), vs0 = *(const f32x4*)(psp + cb4), vs1 = *(const f32x4*)(psp + cb4 + 16);
            f32x4 vn0 = {1.f, 1.f, 1.f, 1.f}, vn1 = vn0, vt0 = {0.f, 0.f, 0.f, 0.f}, vt1 = vt0;
            if (hasn) { vn0 = *(const f32x4*)(ngp + cb4); vn1 = *(const f32x4*)(ngp + cb4 + 16); vt0 = *(const f32x4*)(nsp + cb4); vt1 = *(const f32x4*)(nsp + cb4 + 16); }
            asm volatile("" : "+v"(vg0), "+v"(vg1), "+v"(vp0), "+v"(vp1), "+v"(vs0), "+v"(vs1), "+v"(vn0), "+v"(vn1), "+v"(vt0), "+v"(vt1));
            const f32x4 g0 = vg0 * fac, g1 = vg1 * fac;
            const f32x4 p0 = vp0 * (vs0 + 1.0f), p1 = vp1 * (vs1 + 1.0f);
            f32x4 r0, r1;
#pragma unroll
            for (int i = 0; i < 4; ++i) { r0[i] = __builtin_amdgcn_rcpf(p0[i]); r1[i] = __builtin_amdgcn_rcpf(p1[i]); }
            const f32x4 c0 = vn0 * (vt0 + 1.0f), c1 = vn1 * (vt1 + 1.0f);
            u32x4 hin[2][4];
#pragma unroll
            for (int ai = 0; ai < 2; ++ai)
#pragma unroll
                for (int m = 0; m < 4; ++m) { if (ai == 1 && qm) continue; hin[ai][m] = *(const u32x4*)(sb + lo + (unsigned)((ai * HALF + m * 16) * DM + bj * HALF) * 2u); }
#pragma unroll
            for (int ai = 0; ai < 2; ++ai)
#pragma unroll
                for (int m = 0; m < 4; ++m) { if (ai == 1 && qm) continue;
                    const unsigned off = lo + (unsigned)((ai * HALF + m * 16) * DM + bj * HALF) * 2u;
                    float hv[8]; unpack8(hin[ai][m], hv);
                    float y[8]; float t = 0.f;
#pragma unroll
                    for (int i = 0; i < 4; ++i) { const float a0 = hv[i] * r0[i] + g0[i] * acc[ai][bj][m][0][i], a1 = hv[4 + i] * r1[i] + g1[i] * acc[ai][bj][m][1][i];
                        t += a0 * a0 + a1 * a1; y[i] = a0 * c0[i]; y[4 + i] = a1 * c1[i]; }
                    ss[ai][m] += t;
                    *(u32x4*)(sb + off) = pack8(y); }
            asm volatile("" ::: "memory");
        }
        if (hasn) {
            unsigned long long* sp = ssq + u.pm * BM + rq + wr * 64 + fr;
#pragma unroll
            for (int ai = 0; ai < 2; ++ai)
#pragma unroll
                for (int m = 0; m < 4; ++m) { if (ai == 1 && qm) continue; float t = ss[ai][m]; t += __shfl_xor(t, 16); t += __shfl_xor(t, 32);
                    const float xs = t * SSQ_SCALE; const unsigned xh = (unsigned)(xs * 2.3283064365386963e-10f), xl = (unsigned)__builtin_fmaf(-(float)xh, 4294967296.0f, xs);
                    if (fq == 0) atomicAdd(sp + ai * HALF + m * 16, ((unsigned long long)xh << 32) | xl); }
        }
        }
    }
};
struct EpiGates {
    static constexpr bool PERM = false; static constexpr bool SWAP = true;
    const bf16_t* XA; unsigned* LU; f32x2* SMH;
    const float *ba, *bx, *c8;
    template <int QVV> __device__ __forceinline__ void run(f32x4 (&acc)[2][2][4][2], const Unit& u, int wr, int wc, int fr, int fq) const {
        const int d = u.pn >> 3, q = u.pn & 7;
        const char* xb = (const char*)(XA + (size_t)u.pm * BM * 1024 + q * HALF);
        char* lb = (char*)(LU + ((size_t)(d * 1024 + q * HALF)) * MT + (size_t)u.pm * BM);
        unsigned cl = (unsigned)(wc * 32 + fr), tl = (unsigned)(wr * 64 + 4 * fq);
        asm volatile("" : "+v"(cl), "+v"(tl));
        const float* bb = ba + d * 1024 + q * HALF; const float* xbb = bx + d * 1024 + q * HALF; const float* cbb = c8 + d * 1024 + q * HALF;
        unsigned short xw[2][2][4][4];
#pragma unroll
        for (int n = 0; n < 2; ++n)
#pragma unroll
            for (int ai = 0; ai < 2; ++ai)
#pragma unroll
                for (int m = 0; m < 4; ++m)
#pragma unroll
                    for (int i = 0; i < 4; ++i) xw[n][ai][m][i] = *(const unsigned short*)(xb + ((tl + (unsigned)(ai * HALF + m * 16 + i)) * 1024u + cl + 16u * n) * 2u);
        const int lane_hi = fq;
#pragma unroll
        for (int n = 0; n < 2; ++n) {
            const unsigned ch = cl + 16u * n;
            const float bavn = bb[ch] * (-LOG2E), bxvn = xbb[ch] * (-LOG2E), c8l = cbb[ch] * LOG2E;
#pragma unroll
            for (int ai = 0; ai < 2; ++ai) {
                float Pm[4], Hm[4];
#pragma unroll
                for (int m = 0; m < 4; ++m) {
                    unsigned w[4]; float av[4], uv[4];
#pragma unroll
                    for (int i = 0; i < 4; ++i) {
                        const float er = 1.0f + __builtin_amdgcn_exp2f(__builtin_fmaf(acc[ai][0][m][n][i], -LOG2E, bavn)), ei = 1.0f + __builtin_amdgcn_exp2f(__builtin_fmaf(acc[ai][1][m][n][i], -LOG2E, bxvn));
                        const float rr = __builtin_amdgcn_rcpf(er * ei), rgt = rr * ei, igt = rr * er;
                        const float l2 = c8l * rgt;
                        const float a1 = __builtin_amdgcn_exp2f(__uint_as_float(pk2(l2, 0.f) << 16));
                        const float mult = __builtin_amdgcn_sqrtf(fmaxf(__builtin_fmaf(-a1, a1, 1.0f), 0.0f));
                        w[i] = pk2(l2, mult * igt * __uint_as_float((unsigned)xw[n][ai][m][i] << 16));
                        av[i] = a1; uv[i] = __uint_as_float(w[i] & 0xffff0000u);
                    }
                    *(u32x4*)(lb + ((size_t)ch * MT + tl + (unsigned)(ai * HALF + m * 16)) * 4u) = (u32x4){w[0], w[1], w[2], w[3]};
                    float P = 1.f, H = 0.f;
                    if (d == 0) {
#pragma unroll
                        for (int i = 0; i < 4; ++i) { H = av[i] * H + uv[i]; P *= av[i]; }
                    } else {
#pragma unroll
                        for (int i = 3; i >= 0; --i) { H = av[i] * H + uv[i]; P *= av[i]; }
                    }
#pragma unroll
                    for (int sft = 16; sft < 64; sft <<= 1) {
                        const float Pq = __shfl_xor(P, sft), Hq = __shfl_xor(H, sft);
                        const bool lowhalf = ((lane_hi * 16) & sft) == 0;
                        const bool mine_first = (d == 0) ? lowhalf : !lowhalf;
                        const float Px = mine_first ? P : Pq, Hx = mine_first ? H : Hq, Py = mine_first ? Pq : P, Hy = mine_first ? Hq : H;
                        P = Px * Py; H = Py * Hx + Hy;
                    }
                    Pm[m] = P; Hm[m] = H;
                }
                float P = 1.f, H = 0.f;
                if (d == 0) {
#pragma unroll
                    for (int m = 0; m < 4; ++m) { H = Pm[m] * H + Hm[m]; P *= Pm[m]; }
                } else {
#pragma unroll
                    for (int m = 3; m >= 0; --m) { H = Pm[m] * H + Hm[m]; P *= Pm[m]; }
                }
                if (fq == 0) SMH[((size_t)d * 528 + (size_t)(u.pm * 4 + 2 * ai + wr)) * 1024 + q * HALF + ch] = (f32x2){P, H};
            }
        }
    }
};
struct EpiGate8 {
    static constexpr bool PERM = true; static constexpr bool SWAP = false;
    unsigned char* O; const unsigned long long* ssq; const float* sw; const float* bm;
    template <int QVV> __device__ __forceinline__ void run(f32x4 (&acc)[2][2][4][2], const Unit& u, int wr, int wc, int fr, int fq) const {
        constexpr int nai = (QVV == 2) ? 1 : 2; const int r0 = u.pm * BM + (QVV == 2 ? (u.seg - 1) * HALF : 0);
        char* tb = (char*)(O + (size_t)r0 * NGC + u.pn * BM);
        const int v = u.pm < 4 ? 4 : ((u.pm - 4) >> 5);
        const char* swb = (const char*)(sw + (size_t)v * SWLD + u.pn * BM); const char* bmb = (const char*)(bm + u.pn * BM);
        unsigned lo = (unsigned)((wr * 64 + fr) * NGC + wc * 32 + 8 * fq);
        unsigned co = (unsigned)(wc * 32 + 8 * fq) * 4u;
        asm volatile("" : "+v"(lo), "+v"(co));
        float rs[2][4]; row_rstd(ssq, r0 + wr * 64 + fr, rs);
#pragma unroll
        for (int bj = 0; bj < 2; ++bj) {
            const f32x4 s0 = (*(const f32x4*)(swb + co + bj * HALF * 4) + *(const f32x4*)(bmb + co + bj * HALF * 4)) * (-LOG2E) - 7.994353436858858f,
                        s1 = (*(const f32x4*)(swb + co + bj * HALF * 4 + 16) + *(const f32x4*)(bmb + co + bj * HALF * 4 + 16)) * (-LOG2E) - 7.994353436858858f;
#pragma unroll
            for (int ai = 0; ai < 2; ++ai)
#pragma unroll
                for (int m = 0; m < 4; ++m) { if (ai >= nai) continue;
                    const float rn = rs[ai][m] * (-LOG2E);
                    const f32x4 x0 = acc[ai][bj][m][0] * rn + s0, x1 = acc[ai][bj][m][1] * rn + s1;
                    f32x4 d0, d1;
#pragma unroll
                    for (int i = 0; i < 4; ++i) { d0[i] = __builtin_amdgcn_exp2f(x0[i]); d1[i] = __builtin_amdgcn_exp2f(x1[i]); }
                    d0 = d0 + (1.0f / 255.0f); d1 = d1 + (1.0f / 255.0f);
                    u32x2 w = {0u, 0u};
#pragma unroll
                    for (int i = 0; i < 4; ++i) { const float g0 = fmaxf(__builtin_amdgcn_rcpf(d0[i]), 1.0f), g1 = fmaxf(__builtin_amdgcn_rcpf(d1[i]), 1.0f);
                        w.x = __builtin_amdgcn_cvt_pk_u8_f32(g0, i, w.x); w.y = __builtin_amdgcn_cvt_pk_u8_f32(g1, i, w.y); }
                    *(u32x2*)(tb + lo + (unsigned)((ai * HALF + m * 16) * NGC + bj * HALF)) = w; }
        }
    }
};
struct EpiMerge {
    static constexpr bool PERM = true; static constexpr bool SWAP = false;
    const unsigned char* G; bf16_t* O;
    template <int QVV> __device__ __forceinline__ void run(f32x4 (&acc)[2][2][4][2], const Unit& u, int wr, int wc, int fr, int fq) const {
        const int s = u.seg & 3, s1 = s < 2 ? s + 1 : s, hh = u.seg >> 2, r0 = u.pm * BM + (QVV == 2 ? (hh - 1) * HALF : 0); constexpr int nai = (QVV == 2) ? 1 : 2;
        const char* g0b = (const char*)(G + (size_t)r0 * NGC + s * DM + u.pn * BM); const char* g1b = (const char*)(G + (size_t)r0 * NGC + s1 * DM + u.pn * BM);
        char* ob = (char*)(O + (size_t)r0 * DM + u.pn * BM);
        unsigned co = (unsigned)(wc * 32 + 8 * fq);
        asm volatile("" : "+v"(co));
        unsigned lg = (unsigned)((wr * 64 + fr) * NGC) + co, lw = ((unsigned)((wr * 64 + fr) * DM) + co) * 2u;
        asm volatile("" : "+v"(lg), "+v"(lw));
        const bool last = (s == 2);
        const unsigned lm = last ? 0xffffffffu : 0u;
#pragma unroll
        for (int bj = 0; bj < 2; ++bj) {
            u32x2 g0v[2][4], g1v[2][4];
#pragma unroll
            for (int ai = 0; ai < 2; ++ai)
#pragma unroll
                for (int m = 0; m < 4; ++m) { if (ai >= nai) continue; const unsigned rr = (unsigned)(ai * HALF + m * 16);
                    g0v[ai][m] = *(const u32x2*)(g0b + lg + rr * NGC + bj * HALF); g1v[ai][m] = *(const u32x2*)(g1b + lg + rr * NGC + bj * HALF); }
#pragma unroll
            for (int ai = 0; ai < 2; ++ai)
#pragma unroll
                for (int m = 0; m < 4; ++m) { if (ai >= nai) continue; const unsigned rr = (unsigned)(ai * HALF + m * 16);
                    float o[8];
#pragma unroll
                    for (int n = 0; n < 2; ++n)
#pragma unroll
                        for (int i = 0; i < 4; ++i) {
                            const unsigned w0 = n == 0 ? g0v[ai][m].x : g0v[ai][m].y, w1 = (n == 0 ? g1v[ai][m].x : g1v[ai][m].y) | lm;
                            const float q0 = (float)((w0 >> (8 * i)) & 255u), q1 = (float)((w1 >> (8 * i)) & 255u);
                            const float f = q0 * __builtin_amdgcn_rcpf(q1);
                            const float v = acc[ai][bj][m][n][i] * f; acc[ai][bj][m][n][i] = v; o[n * 4 + i] = v; }
                    if (last) { u32x4 w; w.x = pk2(o[0], o[1]); w.y = pk2(o[2], o[3]); w.z = pk2(o[4], o[5]); w.w = pk2(o[6], o[7]);
                        *(u32x4*)(ob + lw + (rr * DM + bj * HALF) * 2u) = w; } }
            asm volatile("" ::: "memory");
        }
    }
};
}

constexpr int RING_BYTES = 131072;
constexpr int LDSCTL_OFF = RING_BYTES, MISC_OFF = LDSCTL_OFF + 320;
constexpr int LDS_BYTES = 147456;
constexpr int NWAVES = 8;
#ifndef REVMASK
#define REVMASK 0xA2
#endif
#ifndef S2REV
#define S2REV 0
#endif
#ifndef FINREV
#define FINREV 0
#endif
#ifndef REVLAYER
#define REVLAYER 1
#endif
#ifndef WGMCFG
#define WGMCFG 0x444444
#endif
#define WGM_G1 ((WGMCFG >> 20) & 15)
#define WGM_G2 ((WGMCFG >> 16) & 15)
#define WGM_G3 ((WGMCFG >> 12) & 15)
#define WGM_G4 ((WGMCFG >> 8) & 15)
#define WGM_G5 ((WGMCFG >> 4) & 15)
#define WGM_GA (WGMCFG & 15)

typedef GAS unsigned gu32;
#define RLX_AGENT __ATOMIC_RELAXED, __HIP_MEMORY_SCOPE_AGENT
#define LDS_WAIT() asm volatile("s_waitcnt lgkmcnt(0)" ::: "memory")

#define XB_TMO      128
#define XB_XCNT(j)  (256  + 64 * (j))
#define XB_XSUB(j)  (1280 + 64 * (j))
#define XB_XGEN(j)  (2304 + 64 * (j))
#define XB_TOP      3328
#define XB_TOPGEN   3392
#define XCD_BAR_WORDS 3456
#define XB_SPIN_CAP (1u << 18)
__device__ __forceinline__ unsigned xb_ld(unsigned* p)              { return __hip_atomic_load(p, __ATOMIC_RELAXED, __HIP_MEMORY_SCOPE_AGENT); }
__device__ __forceinline__ unsigned xb_add(unsigned* p, unsigned v) { return __hip_atomic_fetch_add(p, v, __ATOMIC_RELAXED, __HIP_MEMORY_SCOPE_AGENT); }
__device__ __forceinline__ unsigned xb_xcc_id() { return (unsigned)__builtin_amdgcn_s_getreg((3 << 11) | 20) & 0xFu; }
#define XB_SPIN(cond, bar) do { unsigned _sp = 0; while (cond) { __builtin_amdgcn_s_sleep(1); \
    if ((++_sp & 255u) == 0u) { if (xb_ld(&(bar)[XB_TMO])) break; if (_sp > XB_SPIN_CAP) { atomicAdd(&(bar)[XB_TMO], 1u); break; } } } } while (0)
struct XcdBarrier { unsigned* bar; unsigned x; volatile LAS unsigned* st; };
__device__ __forceinline__ XcdBarrier xcd_barrier_post(unsigned* bar, volatile LAS unsigned* st) {
    XcdBarrier b; b.bar = bar; b.x = xb_xcc_id(); b.st = st;
    if (threadIdx.x == 0) (void)xb_add(&bar[XB_XCNT(b.x)], 1u);
    return b;
}
__device__ __forceinline__ void xcd_barrier_complete(unsigned* bar, unsigned x, unsigned& nloc, unsigned& nx) {
    const unsigned G = gridDim.x * gridDim.y * gridDim.z;
    unsigned sum, cnt, mine, sp = 0u;
    for (;;) {
        sum = 0u; cnt = 0u; mine = 0u;
#pragma unroll
        for (unsigned j = 0; j < 16; ++j) { const unsigned c = xb_ld(&bar[XB_XCNT(j)]); sum += c; cnt += (c > 0u) ? 1u : 0u; mine = (j == x) ? c : mine; }
        if (sum == G) break;
        __builtin_amdgcn_s_sleep(1);
        if ((++sp & 255u) == 0u) { if (xb_ld(&bar[XB_TMO])) break; if (sp > XB_SPIN_CAP) { atomicAdd(&bar[XB_TMO], 1u); break; } }
    }
    nloc = mine > 0u ? mine : 1u; nx = cnt > 0u ? cnt : 1u;
}
__device__ __forceinline__ void xcd_barrier(const XcdBarrier& b) {
    asm volatile("s_waitcnt vmcnt(0)" ::: "memory");
    __syncthreads();
    if (threadIdx.x == 0) {
        unsigned* bar = b.bar;
        __builtin_amdgcn_s_waitcnt(0);
        unsigned nloc = b.st[0], nx = b.st[1];
        if (nloc == 0u) { xcd_barrier_complete(bar, b.x, nloc, nx); b.st[0] = nloc; b.st[1] = nx; }
        const unsigned old = xb_add(&bar[XB_XSUB(b.x)], 1u);
        const unsigned gen = old / nloc;
        if (old + 1u == (gen + 1u) * nloc) {
            __builtin_amdgcn_fence(__ATOMIC_RELEASE, "agent");
            asm volatile("s_waitcnt vmcnt(0)" ::: "memory");
            const unsigned og = xb_add(&bar[XB_TOP], 1u);
            const unsigned tg = og / nx;
            if (og + 1u == (tg + 1u) * nx) xb_add(&bar[XB_TOPGEN], 1u);
            else XB_SPIN(xb_ld(&bar[XB_TOPGEN]) == tg, bar);
            __builtin_amdgcn_fence(__ATOMIC_ACQUIRE, "agent");
            xb_add(&bar[XB_XGEN(b.x)], 1u);
            asm volatile("s_waitcnt vmcnt(0)" ::: "memory");
        } else {
            XB_SPIN(xb_ld(&bar[XB_XGEN(b.x)]) == gen, bar);
            __builtin_amdgcn_fence(__ATOMIC_ACQUIRE, "agent");
            asm volatile("s_waitcnt vmcnt(0)" ::: "memory");
        }
    }
    __syncthreads();
}

struct Args {
    const float *x, *c, *ctx, *c_ctx, *ada_w, *ada_b, *norm_g, *ffn1_w13, *ffn1_w2, *w_in, *b_merge, *rnn_conv_w, *rnn_conv_b, *lru_w_a, *lru_b_a, *lru_w_x, *lru_b_x,
        *lru_lambda, *sc_conv_w, *attn_sink, *w_branch, *w_out, *ffn2_w13, *ffn2_w2, *final_norm_g;
    float* out; unsigned char* ws; int ph_lo, ph_hi;
};
static_assert(sizeof(Args) == 27 * 8 + 8, "Args has no padding");

__device__ __forceinline__ void transpose_item(const float* W, int K, int N, bf16_t* WT, int k0, int n0, int drow0, LAS float* scr, int lane) {
    f32x4 v[8];
#pragma unroll
    for (int j = 0; j < 8; ++j) v[j] = *(const f32x4*)(W + (size_t)(k0 + (lane >> 3) + 8 * j) * N + n0 + 4 * (lane & 7));
#pragma unroll
    for (int j = 0; j < 8; ++j) { LAS float* d = scr + ((lane >> 3) + 8 * j) * 33 + 4 * (lane & 7); d[0] = v[j].x; d[1] = v[j].y; d[2] = v[j].z; d[3] = v[j].w; }
    LDS_WAIT(); asm volatile("" ::: "memory");
    const int c = lane & 7;
#pragma unroll
    for (int j = 0; j < 4; ++j) { const int n = (lane >> 3) + 8 * j; const LAS float* s = scr + (8 * c) * 33 + n;
        u32x4 o; o.x = pk2(s[0 * 33], s[1 * 33]); o.y = pk2(s[2 * 33], s[3 * 33]); o.z = pk2(s[4 * 33], s[5 * 33]); o.w = pk2(s[6 * 33], s[7 * 33]);
        *(GAS u32x4*)(WT + (size_t)(drow0 + n) * K + k0 + 8 * c) = o; }
    LDS_WAIT(); asm volatile("" ::: "memory");
}
__device__ __forceinline__ void transpose_matrix(const float* W, int K, int N, bf16_t* WT, int rowmode, LAS float* scr, int gw, int ngw, int lane) {
    const int nblk = N / 32, nitems = (K / 64) * nblk;
    for (int it = gw; it < nitems; it += ngw) {
        const int kb = it / nblk, nb = it - kb * nblk, n0 = 32 * nb;
        int drow0 = n0;
        if (rowmode == 1) { const int up = n0 >= DFF, j0 = up ? n0 - DFF : n0; drow0 = 256 * (j0 >> 7) + 128 * up + (j0 & 127); }
        if (rowmode == 2 && n0 >= 5120 && n0 < 6400) {
            const int tb = 5120 + (((n0 - 5120) >> 8) << 8), hh = ((n0 - tb) >> 7) & 1, d0 = (n0 - tb) & 127; drow0 = tb + ((d0 & 32) ? 128 : 0) + hh * 64 + ((d0 >> 6) << 5); }
        if (rowmode == 2 && n0 >= 3072 && n0 < 5120) { const int wh = n0 >= 4096, j0 = n0 - 3072 - wh * 1024; drow0 = 3072 + 256 * (j0 >> 7) + 128 * wh + (j0 & 127); }
        transpose_item(W, K, N, WT, 64 * kb, n0, drow0, scr, lane);
    }
}
__device__ __forceinline__ void convert_weights(const Args& a, int layer, LAS unsigned char* lds, int gw, int ngw, int wave, int lane) {
    LAS float* scr = (LAS float*)(lds + wave * 16384);
    unsigned char* wb = a.ws + WS_W + (size_t)layer * W_REGION;
    transpose_matrix(a.ffn1_w13 + (size_t)layer * DM * 2 * DFF, DM, 2 * DFF, (bf16_t*)(wb + W_13), 1, scr, gw, ngw, lane);
    transpose_matrix(a.ffn1_w2 + (size_t)layer * DFF * DM, DFF, DM, (bf16_t*)(wb + W_2), 0, scr, gw, ngw, lane);
    transpose_matrix(a.w_in + (size_t)layer * DM * INC, DM, INC, (bf16_t*)(wb + W_IN), 2, scr, gw, ngw, lane);
    for (int i = 0; i < 3; ++i)
        transpose_matrix(a.w_branch + ((size_t)layer * 3 + i) * 1024 * DM, 1024, DM, (bf16_t*)(wb + W_BR) + (size_t)i * DM * 1024, 0, scr, gw, ngw, lane);
    transpose_matrix(a.w_out + (size_t)layer * DM * DM, DM, DM, (bf16_t*)(wb + W_OUT), 0, scr, gw, ngw, lane);
    transpose_matrix(a.ffn2_w13 + (size_t)layer * DM * 2 * DFF, DM, 2 * DFF, (bf16_t*)(wb + W_13B), 1, scr, gw, ngw, lane);
    transpose_matrix(a.ffn2_w2 + (size_t)layer * DFF * DM, DFF, DM, (bf16_t*)(wb + W_2B), 0, scr, gw, ngw, lane);
    bf16_t* wg = (bf16_t*)(wb + W_GAT);
    for (int it = gw * 64 + lane; it < 4096 * 16; it += ngw * 64) {
        const int row = it >> 4, din0 = (it & 15) * 8;
        const int tile = row >> 8, gate = (row >> 7) & 1, e = row & 127, d = tile >> 3, q = tile & 7;
        const float* src = (gate ? a.lru_w_x : a.lru_w_a) + ((((size_t)layer * 2 + d) * 8 + q) * 128 + din0) * 128 + e;
        u32x4 o; o.x = pk2(src[0 * 128], src[1 * 128]); o.y = pk2(src[2 * 128], src[3 * 128]); o.z = pk2(src[4 * 128], src[5 * 128]); o.w = pk2(src[6 * 128], src[7 * 128]);
        *(u32x4*)(wg + (size_t)row * 128 + din0) = o;
    }
}
__device__ __forceinline__ void ada_mods(const Args& a, LAS unsigned char* lds, int tid, int wave, int lane) {
    LAS float* sv = (LAS float*)lds;
    for (int i = tid; i < 5 * DM; i += 512) { const int v = i / DM, k = i - v * DM; const float cv = (v < 4) ? a.c[v * DM + k] : a.c_ctx[k]; sv[i] = cv / (1.0f + __expf(-cv)); }
    __syncthreads();
    float* MOD = (float*)(a.ws + WS_MOD);
    LAS f32x4* red4 = (LAS f32x4*)(lds + 40960);
    for (int vb = blockIdx.x; vb < 256; vb += gridDim.x) {
        const int l = vb >> 7, c0 = (vb & 127) * 144;
        const int cg = tid % 36, ks = tid / 36;
        if (ks < 14) {
            const float* W = a.ada_w + (size_t)l * DM * (NMOD * DM) + c0 + cg * 4;
            f32x4 acc[5];
#pragma unroll
            for (int v = 0; v < 5; ++v) acc[v] = (f32x4){0.f, 0.f, 0.f, 0.f};
#pragma unroll 8
            for (int k = ks; k < DM; k += 14) { const f32x4 w = *(const f32x4*)(W + (size_t)k * (NMOD * DM));
#pragma unroll
                for (int v = 0; v < 5; ++v) acc[v] += w * sv[v * DM + k]; }
#pragma unroll
            for (int v = 0; v < 5; ++v) red4[(ks * 36 + cg) * 5 + v] = acc[v];
        }
        __syncthreads();
        for (int o = tid; o < 5 * 144; o += 512) { const int v = o / 144, c = o - v * 144; float sum = 0.f;
#pragma unroll
            for (int q = 0; q < 14; ++q) sum += ((LAS float*)(red4 + (q * 36 + (c >> 2)) * 5 + v))[c & 3];
            MOD[((size_t)l * 5 + v) * (NMOD * DM) + c0 + c] = sum + a.ada_b[l * (NMOD * DM) + c0 + c]; }
        __syncthreads();
    }
}

__device__ __forceinline__ void prescale_phase(const float* srcC, const float* srcL, const float* g, const float* modl, int iscale, bf16_t* U, unsigned long long* ssq, int gw, int ngw, int lane) {
    f32x4 cf[8]; int cv = -1;
    for (int m = gw; m < MT; m += ngw) {
        const bool isc = m < MC; const int v = isc ? 4 : ((m - MC) >> 13);
        if (v != cv) { cv = v; const f32x4* sc = (const f32x4*)(modl + (size_t)v * (NMOD * DM) + iscale * DM) + lane; const f32x4* gp = (const f32x4*)g + lane;
#pragma unroll
            for (int j = 0; j < 8; ++j) cf[j] = gp[64 * j] * (sc[64 * j] + 1.0f); }
        const f32x4* xr = (const f32x4*)(isc ? srcC + (size_t)m * DM : srcL + (size_t)(m - MC) * DM) + lane;
        f32x4 x[8]; float ss = 0.f;
#pragma unroll
        for (int j = 0; j < 8; ++j) { x[j] = __builtin_nontemporal_load(xr + 64 * j); ss += (x[j].x * x[j].x + x[j].y * x[j].y) + (x[j].z * x[j].z + x[j].w * x[j].w); }
        ss = wave_sum(ss);
        if (lane == 0) ssq[m] = (unsigned long long)(ss * pg8::SSQ_SCALE);
        u32x2* o = (u32x2*)(U + (size_t)m * DM) + lane;
#pragma unroll
        for (int j = 0; j < 8; ++j) { const f32x4 y = x[j] * cf[j];
            u32x2 w; w.x = pk2(y.x, y.y); w.y = pk2(y.z, y.w); o[64 * j] = w; }
    }
}
__device__ __forceinline__ void shiftw_phase(const Args& a, int layer, LAS unsigned char* lds, int tid, int gw, int ngw, int lane) {
    LAS float* sh = (LAS float*)lds;
    const float* modl = (const float*)(a.ws + WS_MOD) + (size_t)layer * 5 * (NMOD * DM);
    float* SW = (float*)(a.ws + WS_SW) + (size_t)layer * 3 * 5 * SWLD;
#pragma unroll 1
    for (int kind = 0; kind < 3; ++kind) {
        const int N = kind == 1 ? INC : 2 * DFF, ish = 3 * kind;
        const bf16_t* Wt = (const bf16_t*)(a.ws + WS_W + (size_t)layer * W_REGION + (kind == 0 ? W_13 : (kind == 1 ? W_IN : W_13B)));
        __syncthreads();
        for (int i = tid; i < 5 * DM; i += 512) { const int v = i >> 11, k = i & (DM - 1); sh[i] = modl[(size_t)v * (NMOD * DM) + ish * DM + k]; }
        __syncthreads();
        for (int n = gw; n < N; n += ngw) {
            const bf16_t* wr_ = Wt + (size_t)n * DM + lane * 8;
            float w[4][8];
#pragma unroll
            for (int j = 0; j < 4; ++j) unpack8(*(const u32x4*)(wr_ + 512 * j), w[j]);
            float accv[5];
#pragma unroll
            for (int v = 0; v < 5; ++v) { float s_ = 0.f;
#pragma unroll
                for (int j = 0; j < 4; ++j) { const LAS f32x4* sp = (const LAS f32x4*)(sh + v * DM + lane * 8 + 512 * j); const f32x4 s0 = sp[0], s1 = sp[1];
                    s_ += (w[j][0] * s0[0] + w[j][1] * s0[1]) + (w[j][2] * s0[2] + w[j][3] * s0[3]) + (w[j][4] * s1[0] + w[j][5] * s1[1]) + (w[j][6] * s1[2] + w[j][7] * s1[3]); }
                accv[v] = wave_sum(s_); }
            if (lane < 5) { float r = accv[0]; r = lane == 1 ? accv[1] : r; r = lane == 2 ? accv[2] : r; r = lane == 3 ? accv[3] : r; r = lane == 4 ? accv[4] : r;
                SW[((size_t)kind * 5 + lane) * SWLD + n] = r; }
        }
    }
    __syncthreads();
}

__device__ __forceinline__ void prep_phase(const Args& a, int layer, int gtid, int ngt, int tid, int bx, int G) {
    unsigned char* zb = a.ws + WS_Z; unsigned char* cb = a.ws + WS_CR;
    const bf16_t* ZT = (const bf16_t*)zb;
    bf16_t* XA = (bf16_t*)(cb + C_XA); bf16_t* YS = (bf16_t*)(cb + C_YS); bf16_t* QR = (bf16_t*)(cb + C_QR); bf16_t* KR = (bf16_t*)(cb + C_KR); bf16_t* VT = (bf16_t*)(cb + C_VT);
    const float* cw = a.rnn_conv_w + (size_t)layer * 4 * 1024; const float* cbias = a.rnn_conv_b + (size_t)layer * 1024; const float* sw = a.sc_conv_w + (size_t)layer * 3 * 1024;
#define SEQID(m_) ((m_) < MC ? ((m_) >> 8) : 4 + (((m_) - MC) >> 13))
    for (int it = gtid; it < (MT / 64) * 3 * 128; it += ngt) {
        const int c0 = (it & 127) * 8, q3 = it >> 7, blk = q3 / 3, t3 = q3 - 3 * blk;
        const int m = blk * 64 + (t3 == 0 ? 0 : (t3 == 1 ? 1 : 63));
        const int sid = SEQID(m);
        const float v2 = (m >= 2 && SEQID(m - 2) == sid) ? 1.f : 0.f, v1 = (m >= 1 && SEQID(m - 1) == sid) ? 1.f : 0.f, vp = (m + 1 < MT && SEQID(m + 1) == sid) ? 1.f : 0.f;
        const int r2 = m >= 2 ? m - 2 : 0, r1 = m >= 1 ? m - 1 : 0, rp = m + 1 < MT ? m + 1 : MT - 1;
        float xm2[8], xm1[8], x0[8], xp1[8], o[8];
        unpack8(*(const u32x4*)(ZT + zt(r2, c0)), xm2); unpack8(*(const u32x4*)(ZT + zt(r1, c0)), xm1); unpack8(*(const u32x4*)(ZT + zt(m, c0)), x0); unpack8(*(const u32x4*)(ZT + zt(rp, c0)), xp1);
#pragma unroll
        for (int e = 0; e < 8; ++e) o[e] = cbias[c0 + e] + (cw[c0 + e] * xm2[e]) * v2 + (cw[1024 + c0 + e] * xm1[e]) * v1 + cw[2048 + c0 + e] * x0[e] + (cw[3072 + c0 + e] * xp1[e]) * vp;
        *(u32x4*)(XA + (size_t)m * 1024 + c0) = pack8(o);
    }
    {
        const int c0 = (tid & 127) * 8, strip = tid >> 7;
        const int rpw = (MT + G - 1) / G, rps = (rpw + 3) / 4;
        const int mb = bx * rpw + strip * rps;
        int me = mb + rps; me = me < bx * rpw + rpw ? me : bx * rpw + rpw; me = me < MT ? me : MT;
        float swv[3][8];
#pragma unroll
        for (int e = 0; e < 8; ++e) {
#pragma unroll
            for (int j = 0; j < 3; ++j) swv[j][e] = sw[j * 1024 + c0 + e]; }
#define LDROW(dst, p_, col_) do { const int pc_ = (p_) < 0 ? 0 : ((p_) >= MT ? MT - 1 : (p_)); unpack8(*(const u32x4*)(ZT + zt(pc_, (col_) + c0)), dst); } while (0)
        float pm1[8], p0[8];
        if (mb < me) { LDROW(pm1, mb - 1, 3072); LDROW(p0, mb, 3072); }
#define LDRAW(dst, p_, col_) do { const int pc_ = (p_) < 0 ? 0 : ((p_) >= MT ? MT - 1 : (p_)); dst = *(const u32x4*)(ZT + zt(pc_, (col_) + c0)); } while (0)
        u32x4 qp[2], qb[2];
#pragma unroll
        for (int i = 0; i < 2; ++i) { LDRAW(qp[i], mb + 1 + i, 3072); LDRAW(qb[i], mb + i, 2048); }
#pragma unroll 1
        for (int m = mb; m < me; ++m) {
            float pp1[8], bv[8];
            unpack8(qp[0], pp1); unpack8(qb[0], bv);
            qp[0] = qp[1]; qb[0] = qb[1];
            LDRAW(qp[1], m + 3, 3072); LDRAW(qb[1], m + 2, 2048);
            const int sid = SEQID(m);
            const float v1 = (m >= 1 && SEQID(m - 1) == sid) ? 1.f : 0.f, vp = (m + 1 < MT && SEQID(m + 1) == sid) ? 1.f : 0.f;
            float accy[8];
#pragma unroll
            for (int e = 0; e < 8; ++e) accy[e] = bv[e] * ((swv[0][e] * pm1[e]) * v1 + swv[1][e] * p0[e] + (swv[2][e] * pp1[e]) * vp);
            *(u32x4*)(YS + (size_t)m * 3072 + 1024 + c0) = pack8(accy);
#pragma unroll
            for (int e = 0; e < 8; ++e) { pm1[e] = p0[e]; p0[e] = pp1[e]; }
        }
#undef SEQID
#undef LDROW
#undef LDRAW
    }
    for (int it = gtid; it < NB * 2 * 16 * SEQV; it += ngt) {
        const int s = it % SEQV, r = it / SEQV, dg = r & 15, kvh = (r >> 4) & 1, b = r >> 5;
        const int m = s < CTXL ? b * CTXL + s : MC + b * SEQ + (s - CTXL);
        const u32x4 w = *(const u32x4*)(ZT + zt(m, 6400 + kvh * 128 + dg * 8));
        bf16_t* dp = VT + ((size_t)(b * 2 + kvh) * 128 + dg * 8) * SEQV + s;
        dp[0 * SEQV] = (bf16_t)(w.x & 0xffffu); dp[1 * SEQV] = (bf16_t)(w.x >> 16); dp[2 * SEQV] = (bf16_t)(w.y & 0xffffu); dp[3 * SEQV] = (bf16_t)(w.y >> 16);
        dp[4 * SEQV] = (bf16_t)(w.z & 0xffffu); dp[5 * SEQV] = (bf16_t)(w.z >> 16); dp[6 * SEQV] = (bf16_t)(w.w & 0xffffu); dp[7 * SEQV] = (bf16_t)(w.w >> 16);
    }
}

constexpr int AT_KROW = 272, AT_VROW = 72, AT_KB = 32 * AT_KROW, AT_VB = 128 * AT_VROW, AT_TILE = AT_KB + AT_VB;
__device__ __forceinline__ void attn_tile(f32x16 (&O)[4], float& m_run, float& l_run, const bf16x8 (&qf)[8], const LAS unsigned char* kp, const LAS unsigned char* vp, int mode, int dq, float sc2, int half) {
    f32x16 s;
#pragma unroll
    for (int i = 0; i < 16; ++i) s[i] = 0.f;
    bf16x8 kf[8];
#pragma unroll
    for (int ks = 0; ks < 8; ++ks) kf[ks] = *(const LAS bf16x8*)(kp + 32 * ks);
    s16x4 vlo[2][4], vhi[2][4];
#pragma unroll
    for (int s2 = 0; s2 < 2; ++s2)
#pragma unroll
        for (int dt = 0; dt < 4; ++dt) { const LAS unsigned char* vq = vp + (32 * dt) * AT_VROW + 32 * s2; vlo[s2][dt] = *(const LAS s16x4*)vq; vhi[s2][dt] = *(const LAS s16x4*)(vq + 16); }
#pragma unroll
    for (int ks = 0; ks < 8; ++ks) s = __builtin_amdgcn_mfma_f32_32x32x16_bf16(kf[ks], qf[ks], s, 0, 0, 0);
    float tmax = -3.0e38f;
#pragma unroll
    for (int r = 0; r < 16; ++r) tmax = fmaxf(tmax, s[r]);
    if (mode != 0) {
        const int klo = mode == 1 ? dq - 128 : -100000, khi = mode == 2 ? dq + 128 : 100000;
        tmax = -3.0e38f;
#pragma unroll
        for (int r = 0; r < 16; ++r) { const int key = (r & 3) + 8 * (r >> 2) + 4 * half; float t = s[r];
            if (key < klo || key > khi) t = -1.0e30f;
            s[r] = t; tmax = fmaxf(tmax, t); }
    }
    tmax = fmaxf(tmax, __shfl_xor(tmax, 32));
    const float tms = tmax * sc2, m_new = (tms - m_run > 8.0f) ? tms : m_run;
    if (__builtin_amdgcn_ballot_w64(m_new != m_run) != 0) {
        const float alpha = __builtin_amdgcn_exp2f(m_run - m_new);
        m_run = m_new; l_run *= alpha;
#pragma unroll
        for (int dt = 0; dt < 4; ++dt)
#pragma unroll
            for (int r = 0; r < 16; ++r) O[dt][r] *= alpha;
    }
    float ls = 0.f;
#pragma unroll
    for (int r = 0; r < 16; ++r) { const float p = __builtin_amdgcn_exp2f(__builtin_fmaf(s[r], sc2, -m_run)); s[r] = p; ls += p; }
    l_run += ls;
#pragma unroll
    for (int s2 = 0; s2 < 2; ++s2) {
        u32x4 pw; pw.x = pk2(s[8 * s2 + 0], s[8 * s2 + 1]); pw.y = pk2(s[8 * s2 + 2], s[8 * s2 + 3]); pw.z = pk2(s[8 * s2 + 4], s[8 * s2 + 5]); pw.w = pk2(s[8 * s2 + 6], s[8 * s2 + 7]);
        const bf16x8 pf = __builtin_bit_cast(bf16x8, pw);
#pragma unroll
        for (int dt = 0; dt < 4; ++dt) {
            const bf16x8 vf = __builtin_shufflevector(vlo[s2][dt], vhi[s2][dt], 0, 1, 2, 3, 4, 5, 6, 7);
            O[dt] = __builtin_amdgcn_mfma_f32_32x32x16_bf16(vf, pf, O[dt], 0, 0, 0);
        }
    }
}
__device__ __forceinline__ void attn_phase(const Args& a, int layer, LAS unsigned char* lds, int tid, int wave, int lane) {
    unsigned char* cb = a.ws + WS_CR;
    const bf16_t* QR = (const bf16_t*)(cb + C_QR); const bf16_t* KR = (const bf16_t*)(cb + C_KR); const bf16_t* VT = (const bf16_t*)(cb + C_VT); bf16_t* YS = (bf16_t*)(cb + C_YS);
    const int half = lane >> 5, r31 = lane & 31;
    const float sc2 = 0.08838834764831845f * LOG2E;
    const int nunits = layer == 1 ? 1024 : 1024 + 32;
    const int krow_s = tid >> 4, kc_s = tid & 15, vrow_s = tid >> 2, vc_s = tid & 3;
    const int G_ = gridDim.x, nr = (1024 + G_ - 1) / G_;
    for (int it = 0; ; ++it) {
        int u;
        if (it < nr) { u = blockIdx.x + it * G_; if (u >= 1024) continue; }
        else { u = 1024 + (G_ - 1 - (int)blockIdx.x) + (it - nr) * G_; if (u >= nunits) break; }
        int b, kvh, qb; bool isc;
        if (u < 1024) { isc = false; b = u >> 8; kvh = (u >> 7) & 1; qb = u & 127; } else { const int uc = u - 1024; isc = true; b = uc >> 3; kvh = (uc >> 2) & 1; qb = uc & 3; }
        const int th = wave & 1, g = wave >> 1, hq = kvh * 4 + g, t0 = qb * 64, tq0 = t0 + th * 32;
        const int qrow0 = isc ? b * CTXL : MC + b * SEQ;
        const int klo = isc ? 0 : (t0 >= 128 ? -4 : -(t0 >> 5)), khi = isc ? -1 : ((SEQ - t0) / 32 - 1 < 5 ? (SEQ - t0) / 32 - 1 : 5);
        const int nloc = khi - klo + 1, nt = nloc + 8;
        bf16x8 qf[8];
        { const bf16_t* qp = QR + (size_t)(qrow0 + tq0 + r31) * 1024 + hq * 128 + 8 * half;
#pragma unroll
          for (int ks = 0; ks < 8; ++ks) qf[ks] = *(const bf16x8*)(qp + 16 * ks);
#pragma unroll
          for (int ks = 0; ks < 8; ++ks) asm volatile("" :: "v"(qf[ks])); }
        f32x16 O[4];
#pragma unroll
        for (int dt = 0; dt < 4; ++dt)
#pragma unroll
            for (int r = 0; r < 16; ++r) O[dt][r] = 0.f;
        float m_run = a.attn_sink[layer * 8 + hq] * LOG2E, l_run = half == 0 ? 1.0f : 0.0f;
        const bf16_t* kg0 = KR + (size_t)krow_s * 256 + kvh * 128 + kc_s * 8;
        const bf16_t* vg0 = VT + ((size_t)(b * 2 + kvh) * 128 + vrow_s) * SEQV + vc_s * 8;
#define AT_LOAD(kr_, vr_, i_) do { const int i1_ = (i_), loc_ = i1_ < nloc; const int krow0_ = loc_ ? MC + b * SEQ + t0 + 32 * (klo + i1_) : b * CTXL + 32 * (i1_ - nloc), vcol0_ = loc_ ? CTXL + t0 + 32 * (klo + i1_) : 32 * (i1_ - nloc); \
            kr_ = *(const u32x4*)(kg0 + (size_t)krow0_ * 256); vr_ = *(const u32x4*)(vg0 + vcol0_); } while (0)
#define AT_STORE(kr_, vr_, buf_) do { LAS unsigned char* bp_ = lds + (buf_) * AT_TILE; *(LAS u32x4*)(bp_ + krow_s * AT_KROW + kc_s * 16) = kr_; \
            *(LAS u32x2*)(bp_ + AT_KB + vrow_s * AT_VROW + vc_s * 16) = (u32x2){vr_.x, vr_.y}; *(LAS u32x2*)(bp_ + AT_KB + vrow_s * AT_VROW + vc_s * 16 + 8) = (u32x2){vr_.z, vr_.w}; } while (0)
        u32x4 kregA, vregA, kregB, vregB;
        AT_LOAD(kregA, vregA, 0); AT_STORE(kregA, vregA, 0);
        AT_LOAD(kregA, vregA, 1);
        __syncthreads();
#define AT_STEP(i_, krN_, vrN_, krS_, vrS_) do { const int ii_ = (i_); \
            AT_LOAD(krN_, vrN_, ii_ + 2 < nt ? ii_ + 2 : nt - 1);    \
            const LAS unsigned char* bufp = lds + (ii_ & 1) * AT_TILE; \
            const LAS unsigned char* kp = bufp + r31 * AT_KROW + 16 * half; const LAS unsigned char* vp = bufp + AT_KB + r31 * AT_VROW + 8 * half; \
            { const int kt = klo + ii_, rel = kt - th;             \
              const bool loc = ii_ < nloc, need = !loc || (rel >= -4 && rel <= 4); \
              const int mode = loc ? (rel == -4 ? 1 : (rel == 4 ? 2 : 0)) : 0, dq = loc ? tq0 + r31 - (t0 + 32 * kt) : 0; \
              if (need) attn_tile(O, m_run, l_run, qf, kp, vp, mode, dq, sc2, half); } \
            if (ii_ + 1 < nt) AT_STORE(krS_, vrS_, (ii_ + 1) & 1);    \
            __syncthreads(); } while (0)
#pragma unroll 1
        for (int i = 0; i < nt; i += 2) {
            AT_STEP(i, kregB, vregB, kregA, vregA);
            if (i + 1 < nt) AT_STEP(i + 1, kregA, vregA, kregB, vregB);
        }
#undef AT_STEP
#undef AT_LOAD
#undef AT_STORE
        const float lt = l_run + __shfl_xor(l_run, 32), inv = 1.0f / lt;
        bf16_t* op = YS + (size_t)(qrow0 + tq0 + r31) * 3072 + 2048 + hq * 128 + 4 * half;
#pragma unroll
        for (int dt = 0; dt < 4; ++dt)
#pragma unroll
            for (int rg = 0; rg < 4; ++rg) { u32x2 w; w.x = pk2(O[dt][4 * rg] * inv, O[dt][4 * rg + 1] * inv); w.y = pk2(O[dt][4 * rg + 2] * inv, O[dt][4 * rg + 3] * inv);
                *(u32x2*)(op + 32 * dt + 8 * rg) = w; }
    }
}

__device__ __forceinline__ int chain_chunk(int d, int b, int p) {
    if (d == 0) return p < 2 ? 2 * b + p : 8 + 64 * b + (p - 2);
    return p < 2 ? 2 * b + 1 - p : 8 + 64 * b + 63 - (p - 2);
}
__device__ __forceinline__ void lane_scan8(const u32x4 p0, const u32x4 p1, int d, float (&hl)[8], float (&pl)[8]) {
    const float lv[8] = {bflo(p0.x), bflo(p0.y), bflo(p0.z), bflo(p0.w), bflo(p1.x), bflo(p1.y), bflo(p1.z), bflo(p1.w)};
    const float uv[8] = {bfhi(p0.x), bfhi(p0.y), bfhi(p0.z), bfhi(p0.w), bfhi(p1.x), bfhi(p1.y), bfhi(p1.z), bfhi(p1.w)};
    float H = 0.f, P = 1.f;
    if (d == 0) {
#pragma unroll
        for (int k = 0; k < 8; ++k) { const float av = __builtin_amdgcn_exp2f(lv[k]); H = av * H + uv[k]; P *= av; hl[k] = H; pl[k] = P; }
    } else {
#pragma unroll
        for (int k = 7; k >= 0; --k) { const float av = __builtin_amdgcn_exp2f(lv[k]); H = av * H + uv[k]; P *= av; hl[k] = H; pl[k] = P; }
    }
}
__device__ __forceinline__ void scan_summaries(const Args& a, int gw, int ngw, int lane) {
    const unsigned* LU = (const unsigned*)(a.ws + WS_Z + Z_LA);
    f32x2* SM = (f32x2*)(a.ws + WS_SUMM);
    const int j = lane & 15, g = lane >> 4;
    for (int it = gw; it < 2 * 256 * 66; it += ngw) {
        const int q = it % 66, r = it / 66, c4 = (r & 255) * 4, d = r >> 8;
        const int chunk = 4 * q + g;
        const size_t base = ((size_t)d * 1024 + c4) * MT + (size_t)chunk * 128 + 8 * j;
        u32x4 lw[4], uw[4];
#pragma unroll
        for (int e = 0; e < 4; ++e) { lw[e] = *(const u32x4*)(LU + base + (size_t)e * MT); uw[e] = *(const u32x4*)(LU + base + (size_t)e * MT + 4); }
#pragma unroll
        for (int e = 0; e < 4; ++e) {
            float hl[8], pl[8]; lane_scan8(lw[e], uw[e], d, hl, pl);
            float P = d == 0 ? pl[7] : pl[0], H = d == 0 ? hl[7] : hl[0];
#pragma unroll
            for (int sft = 1; sft < 16; sft <<= 1) {
                const float Pq = __shfl_xor(P, sft, 16), Hq = __shfl_xor(H, sft, 16);
                const bool mine_first = (d == 0) ? ((j & sft) == 0) : ((j & sft) != 0);
                const float Px = mine_first ? P : Pq, Hx = mine_first ? H : Hq, Py = mine_first ? Pq : P, Hy = mine_first ? Hq : H;
                P = Px * Py; H = Py * Hx + Hy;
            }
            if (j == 0) SM[((size_t)d * NCHUNK + chunk) * 1024 + c4 + e] = (f32x2){P, H};
        }
    }
}
__device__ __forceinline__ int chain_half(int d, int b, int p) {
    if (d == 0) return p < 4 ? 4 * b + p : 16 + 128 * b + (p - 4);
    return p < 4 ? 4 * b + 3 - p : 16 + 128 * b + 127 - (p - 4);
}
__device__ __forceinline__ void scan_carries(const Args& a, int bx, int wave, int lane) {
    if (wave != 0 || bx >= 128) return;
    const f32x2* SM = (const f32x2*)(a.ws + WS_SUMM); float* CY = (float*)(a.ws + WS_CARRY);
    const int d = bx >> 6, b = (bx >> 4) & 3, ch = (bx & 15) * 64 + lane;
    float h = 0.f;
#pragma unroll 1
    for (int p0 = 0; p0 < 132; p0 += 22) {
        f32x2 sm[22];
#pragma unroll
        for (int i = 0; i < 22; ++i) sm[i] = SM[((size_t)d * 528 + chain_half(d, b, p0 + i)) * 1024 + ch];
#pragma unroll
        for (int i = 0; i < 22; ++i) { const int hc = chain_half(d, b, p0 + i);
            if ((hc & 1) == d) CY[((size_t)d * NCHUNK + (hc >> 1)) * 1024 + ch] = h;
            h = sm[i].x * h + sm[i].y; }
    }
}
__device__ __forceinline__ float gelu_tanh(float x) { const float y = 0.7978845608028654f * (x + 0.044715f * x * x * x); const float e = __expf(2.0f * y); const float th = 1.0f - 2.0f * __builtin_amdgcn_rcpf(e + 1.0f); return 0.5f * x * (1.0f + th); }
__device__ __forceinline__ void scan_final(const Args& a, int gw, int ngw, int lane, int layer) {
    const unsigned* LU = (const unsigned*)(a.ws + WS_Z + Z_LA); const bf16_t* ZT = (const bf16_t*)(a.ws + WS_Z);
    const float* CY = (const float*)(a.ws + WS_CARRY); bf16_t* YS = (bf16_t*)(a.ws + WS_CR + C_YS);
    const int j = lane & 15, g = lane >> 4;
    const int chunk0 = layer == 1 ? 8 : 0;
    const int NT = (NCHUNK - chunk0) * 32, full = (NT / ngw) * ngw, RT = NT - full; const bool split = RT > 0 && 2 * RT <= ngw;
    const int nmine = full / ngw + ((split ? gw < 2 * RT : gw < RT) ? 1 : 0);
#pragma unroll 1
    for (int it = 0; it < nmine; ++it) {
        const bool tail = split && it * ngw >= full;
        const int wt = tail ? full + (gw >> 1) : it * ngw + gw, eh0 = tail ? (gw & 1) : 0, eh1 = tail ? eh0 + 1 : 2;
        const int chunk = S2REV ? NCHUNK - 1 - (wt >> 5) : chunk0 + (wt >> 5), c8 = (wt & 31) * 32 + g * 8;
        const int row0 = chunk * 128 + 8 * j;
        const float cv = CY[((size_t)(j >> 3) * NCHUNK + chunk) * 1024 + c8 + (j & 7)];
#pragma unroll 1
        for (int eh = eh0; eh < eh1; ++eh) {
            const int c4 = c8 + eh * 4;
            u32x4 lw[2][4], uw[2][4]; u32x2 rgw[8];
#pragma unroll
            for (int d = 0; d < 2; ++d)
#pragma unroll
                for (int e = 0; e < 4; ++e) { const size_t off = ((size_t)d * 1024 + c4 + e) * MT + row0; lw[d][e] = *(const u32x4*)(LU + off); uw[d][e] = *(const u32x4*)(LU + off + 4); }
#pragma unroll
            for (int k = 0; k < 8; ++k) rgw[k] = *(const u32x2*)(ZT + zt(row0 + k, 1024 + c4));
            float acc[8][4];
#pragma unroll
            for (int e = 0; e < 4; ++e) {
#pragma unroll
                for (int d = 0; d < 2; ++d) {
                    float hl[8], pl[8]; lane_scan8(lw[d][e], uw[d][e], d, hl, pl);
                    float Pi = d == 0 ? pl[7] : pl[0], Hi = d == 0 ? hl[7] : hl[0];
#pragma unroll
                    for (int sft = 1; sft < 16; sft <<= 1) {
                        const float Pp = d == 0 ? __shfl_up(Pi, sft, 16) : __shfl_down(Pi, sft, 16), Hp = d == 0 ? __shfl_up(Hi, sft, 16) : __shfl_down(Hi, sft, 16);
                        const bool has = d == 0 ? (j >= sft) : (j + sft <= 15);
                        if (has) { Hi = Pi * Hp + Hi; Pi = Pi * Pp; }
                    }
                    float Pe = d == 0 ? __shfl_up(Pi, 1, 16) : __shfl_down(Pi, 1, 16), He = d == 0 ? __shfl_up(Hi, 1, 16) : __shfl_down(Hi, 1, 16);
                    if (d == 0 ? (j == 0) : (j == 15)) { Pe = 1.f; He = 0.f; }
                    const float c0 = __shfl(cv, eh * 4 + e + 8 * d, 16);
                    const float sj = Pe * c0 + He;
#pragma unroll
                    for (int k = 0; k < 8; ++k) { const float hv = hl[k] + pl[k] * sj; if (d == 0) acc[k][e] = hv; else acc[k][e] += hv; }
                }
            }
#pragma unroll
            for (int k = 0; k < 8; ++k) { const float r0 = bflo(rgw[k].x), r1 = bfhi(rgw[k].x), r2 = bflo(rgw[k].y), r3 = bfhi(rgw[k].y);
                u32x2 w; w.x = pk2(acc[k][0] * gelu_tanh(r0), acc[k][1] * gelu_tanh(r1)); w.y = pk2(acc[k][2] * gelu_tanh(r2), acc[k][3] * gelu_tanh(r3));
                *(u32x2*)(YS + (size_t)(row0 + k) * 3072 + c4) = w; }
        }
    }
}

constexpr int NPH = 32;
__device__ __forceinline__ Args load_args() {
#if defined(__HIP_DEVICE_COMPILE__)
    typedef const __attribute__((address_space(4))) Args* KA;
    KA p = (KA)__builtin_amdgcn_kernarg_segment_ptr(); asm volatile("" : "+s"(p)); return *(const Args*)p;
#else
    return Args{};
#endif
}
#define PHASE_BEGIN() const Args a = load_args(); int tid = threadIdx.x; asm volatile("" : "+v"(tid)); const int lane = tid & 63, wave = __builtin_amdgcn_readfirstlane(tid >> 6); \
    const int G = gridDim.x, bx = blockIdx.x, gw = bx * NWAVES + wave, ngw = G * NWAVES, gtid = bx * 512 + tid, ngt = G * 512; \
    unsigned char* ws = a.ws; float* MOD = (float*)(ws + WS_MOD); float* C8 = (float*)(ws + WS_C8); unsigned long long* SSQ = (unsigned long long*)(ws + WS_SSQ); float* SW = (float*)(ws + WS_SW) + (size_t)layer * 3 * 5 * SWLD; bf16_t* U = (bf16_t*)(ws + WS_H); bf16_t* MG = (bf16_t*)a.out;     \
    unsigned char* wb = ws + WS_W + (size_t)layer * W_REGION; unsigned char* zb = ws + WS_Z; unsigned char* cb = ws + WS_CR; \
    const float* modl = MOD + (size_t)layer * 5 * (NMOD * DM); \
    (void)SSQ; (void)SW; (void)lane; (void)wave; (void)gw; (void)ngw; (void)gtid; (void)ngt; (void)C8; (void)U; (void)wb; (void)zb; (void)cb; (void)modl; (void)MG; (void)bx;

__global__ void __launch_bounds__(NWAVES * 64, 2) fwd_kernel(Args a_param) {
    extern __shared__ __attribute__((aligned(16))) unsigned char lds_raw[];
    LAS unsigned char* lds = (LAS unsigned char*)lds_raw;
    int lo, hi; XcdBarrier bar;
    {
        const Args a = load_args();
        volatile LAS unsigned* MISC = (volatile LAS unsigned*)(lds + MISC_OFF);
        unsigned* ctl = (unsigned*)(a.ws + WS_CTL);
        for (int u = threadIdx.x; u < (LDS_BYTES - LDSCTL_OFF) / 4; u += NWAVES * 64) ((LAS unsigned*)(lds + LDSCTL_OFF))[u] = 0u;
        __syncthreads();
        bar.bar = ctl + CW_BAR; bar.x = 0; bar.st = MISC + 8;
        if (MK_ONE_LAUNCH) bar = xcd_barrier_post(ctl + CW_BAR, MISC + 8);
        lo = a.ph_lo; hi = a.ph_hi;
    }
#ifndef ENMASK
#define ENMASK 0x1ffff
#endif
#define IN(k) (lo <= (k) && (k) < hi)
#define INP(p) (((ENMASK >> (p)) & 1) && IN(pb + (p)))
#define SEAM(k) do { xcd_barrier(bar); } while (0)
#ifndef DUPMASK
#define DUPMASK 0
#endif
#define REP(p) _Pragma("nounroll") for (int rep_ = 0; rep_ < 1 + ((DUPMASK >> (p)) & 1); ++rep_)

    if (((ENMASK >> 15) & 1) && IN(0)) {
        const int layer = 0; PHASE_BEGIN();
        REP(16) ada_mods(a, lds, tid, wave, lane);
        for (int i = gtid; i < 2 * 2 * 1024; i += ngt) { const float lam = a.lru_lambda[i]; C8[i] = -8.0f * log1pf(expf(-lam)); }
        for (int i = gtid; i < 128 * 32; i += ngt) { const float inv = powf(10000.0f, -(float)(i & 31) * (1.0f / 32.0f)); float sn, cs; sincosf((float)(i >> 5) * inv, &sn, &cs);
            ((float*)(ws + WS_ROPE))[i] = cs; ((float*)(ws + WS_ROPE))[4096 + i] = sn; }
        REP(17) convert_weights(a, 0, lds, gw, ngw, wave, lane);
        SEAM(0);
    }
#pragma nounroll
    for (int layer = 0; layer < 2; ++layer) {
        const int pb = 1 + 15 * layer;
        if (layer == 0 && INP(0)) { PHASE_BEGIN();
            shiftw_phase(a, 0, lds, tid, gw, ngw, lane);
            REP(0) prescale_phase(a.ctx, a.x, a.norm_g, modl, 1, U, SSQ, gw, ngw, lane);
            SEAM(pb + 0);
        }
        if (INP(1)) { PHASE_BEGIN();
            pg8::Gemm g{(const char*)U, (const char*)(wb + W_13), DM, DM, DM}; pg8::Order<4> S; S.ragged = false; S.lda2 = 0; S.so.init(MT, 2 * DFF, G, bx, WGM_G1, ((REVMASK >> 0) & 1) ^ (layer & REVLAYER)); S.pm0 = 0; S.lda2 = DM * 2;
            pg8::EpiSwiglu E{(bf16_t*)(zb + Z_ACT), SSQ + (size_t)(layer * 3 + 0) * MT, SW + (size_t)0 * 5 * SWLD};
            pg8::gemm_phase(lds, g, S, E, tid); if ((DUPMASK >> 1) & 1) { asm volatile("" : "+v"(tid)); pg8::gemm_phase(lds, g, S, E, tid); }
            asm volatile("" : "+v"(tid)); pg8::gemm_phase<pg8::EpiSwiglu, pg8::Order<4>, 2>(lds, g, S, E, tid);
            SEAM(pb + 1);
        }
        if (INP(2)) { PHASE_BEGIN();
            pg8::Gemm g{(const char*)(zb + Z_ACT), (const char*)(wb + W_2), DFF, DFF, DFF}; pg8::Order<3> S; S.ragged = (G == 256); S.lda2 = DFF * 2; S.so.init(S.ragged ? ML : MT, DM, G, bx, WGM_G2, ((REVMASK >> 1) & 1) ^ (layer & REVLAYER)); S.pm0 = 0;
            pg8::EpiResid E{U, modl + 2 * DM, a.norm_g + (size_t)(layer * 3 + 0) * DM, modl + 1 * DM, a.norm_g + (size_t)(layer * 3 + 1) * DM, modl + 4 * DM, SSQ + (size_t)(layer * 3 + 1) * MT, 0.5f};
            pg8::gemm_phase(lds, g, S, E, tid);
            { pg8::OrderQ SQ{bx, DFF * 2, S.ragged}; asm volatile("" : "+v"(tid)); pg8::gemm_phase<pg8::EpiResid, pg8::OrderQ, 1>(lds, g, SQ, E, tid); }
            SEAM(pb + 2);
        }
        if (INP(4)) { PHASE_BEGIN();
            pg8::Gemm g{(const char*)U, (const char*)(wb + W_IN), DM, DM, DM}; pg8::Order<4> S; S.ragged = false; S.lda2 = 0; S.so.init(MT, NZS, G, bx, WGM_G3, ((REVMASK >> 2) & 1) ^ (layer & REVLAYER)); S.pm0 = 0; S.lda2 = DM * 2;
            pg8::EpiStore E{(bf16_t*)zb, 256, (size_t)MT * 256, SSQ + (size_t)(layer * 3 + 1) * MT, SW + (size_t)1 * 5 * SWLD, (bf16_t*)(cb + C_QR), (bf16_t*)(cb + C_KR), (const float*)(ws + WS_ROPE), (bf16_t*)(cb + C_XA), a.rnn_conv_w + (size_t)layer * 4 * 1024, a.rnn_conv_b + (size_t)layer * 1024};
            pg8::gemm_phase(lds, g, S, E, tid); if ((DUPMASK >> 4) & 1) { asm volatile("" : "+v"(tid)); pg8::gemm_phase(lds, g, S, E, tid); }
            asm volatile("" : "+v"(tid)); pg8::gemm_phase<pg8::EpiStore, pg8::Order<4>, 2>(lds, g, S, E, tid);
            SEAM(pb + 4);
        }
        if (INP(5)) { PHASE_BEGIN(); REP(5) prep_phase(a, layer, gtid, ngt, tid, bx, G); SEAM(pb + 5); }
        if (INP(6)) { PHASE_BEGIN();
            const bool cvt1 = (layer == 0), cvfirst = ((bx >> 3) & 1) == 0;
            if (cvt1 && cvfirst) { convert_weights(a, 1, lds, gw, ngw, wave, lane); __syncthreads(); }
#ifndef NO_GA
            int gaK = 128; asm volatile("" : "+s"(gaK));     pg8::Gemm g{(const char*)(cb + C_XA), (const char*)(wb + W_GAT), 1024, 128, gaK}; pg8::Order<1> S; S.ragged = false; S.lda2 = 0; S.so.init(MT, 4096, G, bx, WGM_GA, ((REVMASK >> 3) & 1) ^ (layer & REVLAYER)); S.pm0 = 0;
            pg8::EpiGates E{(const bf16_t*)(cb + C_XA), (unsigned*)(zb + Z_LA), (f32x2*)(ws + WS_SUMM), a.lru_b_a + (size_t)layer * 2048, a.lru_b_x + (size_t)layer * 2048, C8 + (size_t)layer * 2048};
            pg8::gemm_phase(lds, g, S, E, tid); if ((DUPMASK >> 6) & 1) { asm volatile("" : "+v"(tid)); pg8::gemm_phase(lds, g, S, E, tid); }
#endif
#ifndef NO_ATT
            REP(15) attn_phase(a, layer, lds, tid, wave, lane);
#endif
            if (cvt1 && !cvfirst) { __syncthreads(); convert_weights(a, 1, lds, gw, ngw, wave, lane); }
            SEAM(pb + 6);
        }
        if (INP(7)) { PHASE_BEGIN(); scan_carries(a, bx, wave, lane); SEAM(pb + 7); }
        if (INP(8)) { PHASE_BEGIN(); REP(8) scan_final(a, gw, ngw, lane, layer); SEAM(pb + 8); }
        if (INP(9)) { PHASE_BEGIN();
            const bool sw1 = (layer == 0), swfirst = ((bx >> 3) & 1) != 0;
            if (sw1 && swfirst) shiftw_phase(a, 1, lds, tid, gw, ngw, lane);
            pg8::Gemm g{(const char*)U, (const char*)(wb + W_IN + (size_t)NZS * DM * 2), DM, DM, DM}; pg8::Order<4> S; S.ragged = false; S.lda2 = 0; S.so.init(layer == 1 ? ML : MT, NGC, G, bx, WGM_G3, ((REVMASK >> 4) & 1) ^ (layer & REVLAYER)); S.pm0 = layer == 1 ? 4 : 0; S.lda2 = DM * 2;
            pg8::EpiGate8 E{(unsigned char*)(zb + Z_G), SSQ + (size_t)(layer * 3 + 1) * MT, SW + (size_t)1 * 5 * SWLD + NZS, a.b_merge + (size_t)layer * 3 * DM};
            pg8::gemm_phase(lds, g, S, E, tid); if ((DUPMASK >> 9) & 1) { asm volatile("" : "+v"(tid)); pg8::gemm_phase(lds, g, S, E, tid); }
            asm volatile("" : "+v"(tid)); pg8::gemm_phase<pg8::EpiGate8, pg8::Order<4>, 2>(lds, g, S, E, tid);
            if (sw1 && !swfirst) shiftw_phase(a, 1, lds, tid, gw, ngw, lane);
            SEAM(pb + 9);
        }
        if (INP(10)) { PHASE_BEGIN();
            pg8::Gemm g{(const char*)(cb + C_YS), (const char*)(wb + W_BR), 3072, 1024, 1024}; pg8::Order<2> S; S.ragged = false; S.lda2 = 3072 * 2; S.so.init(layer == 1 ? ML : MT, DM, G, bx, WGM_G4, ((REVMASK >> 5) & 1) ^ (layer & REVLAYER)); S.pm0 = layer == 1 ? 4 : 0;
            pg8::EpiMerge E{(const unsigned char*)(zb + Z_G), MG};
            pg8::gemm_phase(lds, g, S, E, tid); if ((DUPMASK >> 10) & 1) { asm volatile("" : "+v"(tid)); pg8::gemm_phase(lds, g, S, E, tid); }
            asm volatile("" : "+v"(tid)); pg8::gemm_phase<pg8::EpiMerge, pg8::Order<2>, 2>(lds, g, S, E, tid);
            SEAM(pb + 10);
        }
        if (INP(11)) { PHASE_BEGIN();
            pg8::Gemm g{(const char*)MG, (const char*)(wb + W_OUT), DM, DM, DM}; pg8::Order<3> S; S.ragged = (G == 256 && layer == 0); S.lda2 = DM * 2; S.so.init(layer == 1 || S.ragged ? ML : MT, DM, G, bx, WGM_G5, ((REVMASK >> 6) & 1) ^ (layer & REVLAYER)); S.pm0 = layer == 1 ? 4 : 0;
            pg8::EpiResid E{U, modl + 5 * DM, a.norm_g + (size_t)(layer * 3 + 1) * DM, modl + 4 * DM, a.norm_g + (size_t)(layer * 3 + 2) * DM, modl + 7 * DM, SSQ + (size_t)(layer * 3 + 2) * MT, 1.0f};
            pg8::gemm_phase(lds, g, S, E, tid);
            { pg8::OrderQ SQ{bx, DM * 2, S.ragged}; asm volatile("" : "+v"(tid)); pg8::gemm_phase<pg8::EpiResid, pg8::OrderQ, 1>(lds, g, SQ, E, tid); }
            SEAM(pb + 11);
        }
        if (INP(13)) { PHASE_BEGIN();
            pg8::Gemm g{(const char*)U, (const char*)(wb + W_13B), DM, DM, DM}; pg8::Order<4> S; S.ragged = false; S.lda2 = 0; S.so.init(layer == 1 ? ML : MT, 2 * DFF, G, bx, WGM_G1, ((REVMASK >> 7) & 1) ^ (layer & REVLAYER)); S.pm0 = layer == 1 ? 4 : 0; S.lda2 = DM * 2;
            pg8::EpiSwiglu E{(bf16_t*)(zb + Z_ACT), SSQ + (size_t)(layer * 3 + 2) * MT, SW + (size_t)2 * 5 * SWLD};
            pg8::gemm_phase(lds, g, S, E, tid); if ((DUPMASK >> 13) & 1) { asm volatile("" : "+v"(tid)); pg8::gemm_phase(lds, g, S, E, tid); }
            asm volatile("" : "+v"(tid)); pg8::gemm_phase<pg8::EpiSwiglu, pg8::Order<4>, 2>(lds, g, S, E, tid);
            SEAM(pb + 13);
        }
        if (INP(14)) { PHASE_BEGIN();
            pg8::Gemm g{(const char*)(zb + Z_ACT), (const char*)(wb + W_2B), DFF, DFF, DFF}; pg8::Order<3> S; S.ragged = (G == 256 && layer == 0); S.lda2 = DFF * 2; S.so.init(layer == 1 || S.ragged ? ML : MT, DM, G, bx, WGM_G2, ((REVMASK >> 8) & 1) ^ (layer & REVLAYER)); S.pm0 = layer == 1 ? 4 : 0;
            pg8::EpiResid E{U, modl + 8 * DM, a.norm_g + (size_t)(layer * 3 + 2) * DM, modl + 7 * DM, layer == 0 ? a.norm_g + (size_t)3 * DM : (const float*)nullptr, modl + 5 * (NMOD * DM) + 1 * DM, SSQ + (size_t)3 * MT, 0.5f};
            pg8::gemm_phase(lds, g, S, E, tid);
            { pg8::OrderQ SQ{bx, DFF * 2, S.ragged}; asm volatile("" : "+v"(tid)); pg8::gemm_phase<pg8::EpiResid, pg8::OrderQ, 1>(lds, g, SQ, E, tid); }
            SEAM(pb + 14);
        }
    }
    if (((ENMASK >> 16) & 1) && IN(31)) {
        const int layer = 1; PHASE_BEGIN();
        f32x4 gq[8];
        { const f32x4* gp = (const f32x4*)a.final_norm_g + lane;
#pragma unroll
          for (int j = 0; j < 8; ++j) gq[j] = gp[64 * j]; }
        for (int m = gw; m < ML; m += ngw) {
            const u32x2* hr = (const u32x2*)(U + (size_t)(MC + m) * DM) + lane; f32x4* xr = (f32x4*)(a.out + (size_t)m * DM) + lane;
            f32x4 x[8]; float ss = 0.f;
#pragma unroll
            for (int j = 0; j < 8; ++j) { const u32x2 w = hr[64 * j]; x[j] = (f32x4){bflo(w.x), bfhi(w.x), bflo(w.y), bfhi(w.y)}; ss += (x[j].x * x[j].x + x[j].y * x[j].y) + (x[j].z * x[j].z + x[j].w * x[j].w); }
            const float rstd = 1.0f / sqrtf(wave_sum(ss) * (1.0f / DM) + EPS);
#pragma unroll
            for (int j = 0; j < 8; ++j) xr[64 * j] = (x[j] * rstd) * gq[j];
        }
    }
#undef IN
#undef INP
#undef SEAM
}

extern "C" void kernel_launch(void* const* d_in, const int* in_sizes, int n_in, void* d_out, int out_size, void* d_ws, size_t ws_size, hipStream_t stream) {
    static int grid = 0;
    if (grid == 0) {
        if (n_in != 25 || out_size != ML * DM || ws_size < WS_END) { fprintf(stderr, "kernel_launch: unexpected shapes (n_in %d, out %d, ws %zu, need %zu)\n", n_in, out_size, ws_size, (size_t)WS_END); grid = -1; return; }
        int dev = 0, cus = 0;
        if (hipGetDevice(&dev) != hipSuccess || hipDeviceGetAttribute(&cus, hipDeviceAttributeMultiprocessorCount, dev) != hipSuccess) { grid = -1; return; }
        if (hipFuncSetAttribute((const void*)fwd_kernel, hipFuncAttributeMaxDynamicSharedMemorySize, LDS_BYTES) != hipSuccess) { fprintf(stderr, "kernel_launch: hipFuncSetAttribute failed\n"); grid = -1; return; }
        int per_cu = 0;
        if (hipOccupancyMaxActiveBlocksPerMultiprocessor(&per_cu, (const void*)fwd_kernel, NWAVES * 64, LDS_BYTES) != hipSuccess || per_cu < 1) { fprintf(stderr, "kernel_launch: occupancy query reports %d\n", per_cu); }
        (void)hipGetLastError();
        grid = cus;
    }
    if (grid < 0) return;
    (void)hipMemsetAsync((char*)d_ws + WS_CTL, 0, CTL_ZERO_BYTES, stream);
    Args a{};
    const float** p = (const float**)&a;
    for (int i = 0; i < 25; ++i) p[i] = (const float*)d_in[i];
    a.out = (float*)d_out; a.ws = (unsigned char*)d_ws;
#if MK_ONE_LAUNCH
    a.ph_lo = 0; a.ph_hi = NPH;
    hipLaunchKernelGGL(fwd_kernel, dim3(grid), dim3(NWAVES * 64), LDS_BYTES, stream, a);
#else
    for (int ph = 0; ph < NPH; ++ph) { a.ph_lo = ph; a.ph_hi = ph + 1; hipLaunchKernelGGL(fwd_kernel, dim3(grid), dim3(NWAVES * 64), LDS_BYTES, stream, a); }
#endif
}
```
